# Optimizing an MI355X kernel written in HIP

```python
import math
import jax, jax.numpy as jnp
from jax import lax
import numpy as np

D_MODEL = 1024
BATCH = 8
SEQ = 2048
DEPTH = 1

CHUNK = 64
Q_BLOCK = 128
HEAD_DIM = 64
N_DIFF_HEADS = 4
DIFF_V_DIM = 2 * HEAD_DIM
N_SB_HEADS = 8
DIFF_WIDTH = N_DIFF_HEADS * DIFF_V_DIM
SB_WIDTH = N_SB_HEADS * HEAD_DIM
MIX_WIDTH = DIFF_WIDTH + SB_WIDTH
DIFF_QK_WIDTH = N_DIFF_HEADS * 2 * HEAD_DIM
IN_SPLITS = (DIFF_QK_WIDTH, 2 * DIFF_QK_WIDTH, 2 * DIFF_QK_WIDTH + DIFF_WIDTH,
             2 * DIFF_QK_WIDTH + DIFF_WIDTH + SB_WIDTH,
             2 * DIFF_QK_WIDTH + DIFF_WIDTH + 2 * SB_WIDTH)
IN_WIDTH = 2 * DIFF_QK_WIDTH + DIFF_WIDTH + 3 * SB_WIDTH
D_FF = 4 * D_MODEL
EPS = 1e-6
NEG_INF = -1e30

kernel_name = "hymba_diffattn_stickbreak_sqrelu_block"


def rms_norm(x, g):
    xf = x.astype(jnp.float32)
    y = xf * lax.rsqrt(jnp.mean(xf * xf, axis=-1, keepdims=True) + EPS)
    return (y * g.astype(jnp.float32)).astype(x.dtype)


def alibi_slopes(n_heads):
    return jnp.exp2(-8.0 * jnp.arange(1, n_heads + 1, dtype=jnp.float32) / n_heads)


def diff_attention(q, k, v, lam, lambda_init, subln_g):
    B, S, H = q.shape[0], q.shape[1], q.shape[2]
    scale = 1.0 / math.sqrt(HEAD_DIM)
    slopes = alibi_slopes(H)
    outs = []
    for i in range(S // Q_BLOCK):
        t0, t1 = i * Q_BLOCK, (i + 1) * Q_BLOCK
        qb = q[:, t0:t1].astype(jnp.float32)
        kb = k[:, :t1].astype(jnp.float32)
        scores = jnp.einsum('bqhmd,bkhmd->bhmqk', qb, kb) * scale
        tpos = jnp.arange(t0, t1)
        spos = jnp.arange(t1)
        mask = (spos // CHUNK)[None, :] <= (tpos // CHUNK)[:, None]
        dist = jnp.abs(tpos[:, None] - spos[None, :]).astype(jnp.float32)
        bias = -slopes[:, None, None] * dist
        scores = jnp.where(mask[None, None, None], scores + bias[None, :, None], NEG_INF)
        p = jax.nn.softmax(scores, axis=-1)
        attn = p[:, :, 0] - lam * p[:, :, 1]
        outs.append(jnp.einsum('bhqk,bkhe->bqhe', attn, v[:, :t1].astype(jnp.float32)))
    o = jnp.concatenate(outs, axis=1)
    o = rms_norm(o, subln_g) * (1.0 - lambda_init)
    return o.reshape(B, S, H * DIFF_V_DIM).astype(q.dtype)


def stick_breaking(q, k, v, norm_g):
    B, S, H = q.shape[0], q.shape[1], q.shape[2]
    scale = 1.0 / math.sqrt(HEAD_DIM)
    outs = []
    for i in range(S // Q_BLOCK):
        t0, t1 = i * Q_BLOCK, (i + 1) * Q_BLOCK
        qb = q[:, t0:t1].astype(jnp.float32)
        kb = k[:, :t1].astype(jnp.float32)
        z = jnp.einsum('bqhd,bkhd->bhqk', qb, kb) * scale
        tpos = jnp.arange(t0, t1)
        spos = jnp.arange(t1)
        mask = (spos[None, :] < tpos[:, None])[None, None]
        neg_log_1m_beta = jnp.where(mask, jax.nn.softplus(z), 0.0)
        suffix = lax.cumsum(neg_log_1m_beta, axis=3, reverse=True)
        log_a = jax.nn.log_sigmoid(z) - (suffix - neg_log_1m_beta)
        a = jnp.where(mask, jnp.exp(log_a), 0.0)
        outs.append(jnp.einsum('bhqk,bkhd->bqhd', a, v[:, :t1].astype(jnp.float32)))
    o = jnp.concatenate(outs, axis=1)
    o = rms_norm(o, norm_g)
    return o.reshape(B, S, H * HEAD_DIM).astype(q.dtype)


def setup_inputs(seed: int = 0) -> dict:
    key = jax.random.key(seed)
    ks = jax.random.split(key, 16)
    f32 = jnp.float32
    def nrm(k, shape, scale):
        return jax.random.normal(k, shape, f32) * scale
    return {
        "x": nrm(ks[0], (BATCH, SEQ, D_MODEL), 1.0),
        "norm1_g": 1.0 + nrm(ks[1], (DEPTH, D_MODEL), 0.02),
        "w_in": nrm(ks[2], (DEPTH, D_MODEL, IN_WIDTH), D_MODEL ** -0.5),
        "lambda_q1": nrm(ks[3], (DEPTH, HEAD_DIM), 0.1),
        "lambda_k1": nrm(ks[4], (DEPTH, HEAD_DIM), 0.1),
        "lambda_q2": nrm(ks[5], (DEPTH, HEAD_DIM), 0.1),
        "lambda_k2": nrm(ks[6], (DEPTH, HEAD_DIM), 0.1),
        "diff_subln_g": 1.0 + nrm(ks[7], (DEPTH, DIFF_V_DIM), 0.02),
        "sb_norm_g": 1.0 + nrm(ks[8], (DEPTH, HEAD_DIM), 0.02),
        "w_out": nrm(ks[9], (DEPTH, MIX_WIDTH, D_MODEL), MIX_WIDTH ** -0.5),
        "norm2_g": 1.0 + nrm(ks[10], (DEPTH, D_MODEL), 0.02),
        "w_up": nrm(ks[11], (DEPTH, D_MODEL, D_FF), D_MODEL ** -0.5),
        "w_down": nrm(ks[12], (DEPTH, D_FF, D_MODEL), D_FF ** -0.5),
        "final_norm_g": 1.0 + nrm(ks[13], (D_MODEL,), 0.02),
    }


def reference(x, norm1_g, w_in, lambda_q1, lambda_k1, lambda_q2, lambda_k2,
              diff_subln_g, sb_norm_g, w_out, norm2_g, w_up, w_down, final_norm_g):
    B, S = x.shape[0], x.shape[1]
    h = x
    for l in range(DEPTH):
        lambda_init = 0.8 - 0.6 * math.exp(-0.3 * l)
        n = rms_norm(h, norm1_g[l])
        proj = jnp.einsum('bsd,de->bse', n, w_in[l])
        dq, dk, dv, sq, sk, sv = jnp.split(proj, IN_SPLITS, axis=-1)
        dq = dq.reshape(B, S, N_DIFF_HEADS, 2, HEAD_DIM)
        dk = dk.reshape(B, S, N_DIFF_HEADS, 2, HEAD_DIM)
        dv = dv.reshape(B, S, N_DIFF_HEADS, DIFF_V_DIM)
        sq = sq.reshape(B, S, N_SB_HEADS, HEAD_DIM)
        sk = sk.reshape(B, S, N_SB_HEADS, HEAD_DIM)
        sv = sv.reshape(B, S, N_SB_HEADS, HEAD_DIM)
        lam = (jnp.exp(jnp.sum(lambda_q1[l].astype(jnp.float32) * lambda_k1[l].astype(jnp.float32)))
               - jnp.exp(jnp.sum(lambda_q2[l].astype(jnp.float32) * lambda_k2[l].astype(jnp.float32)))
               + lambda_init)
        o_diff = diff_attention(dq, dk, dv, lam, lambda_init, diff_subln_g[l])
        o_sb = stick_breaking(sq, sk, sv, sb_norm_g[l])
        mixed = jnp.concatenate([o_diff, o_sb], axis=-1)
        h = h + jnp.einsum('bse,ed->bsd', mixed, w_out[l])
        n2 = rms_norm(h, norm2_g[l])
        u = jnp.einsum('bsd,df->bsf', n2, w_up[l])
        u = jnp.square(jax.nn.relu(u))
        h = h + jnp.einsum('bsf,fd->bsd', u, w_down[l])
    return rms_norm(h, final_norm_g)
```

```cpp
#include <hip/hip_runtime.h>
#include <hip/hip_cooperative_groups.h>
#include <cstdio>
#include <cstdint>
namespace cg = cooperative_groups;
#define MK_N_LAUNCHES 1
namespace pg8 {
#define PG8_LAS __attribute__((address_space(3)))
typedef unsigned short bf16_t;
typedef short bf16x8 __attribute__((ext_vector_type(8)));
typedef float f32x4 __attribute__((ext_vector_type(4)));
typedef unsigned u32x4 __attribute__((ext_vector_type(4)));
constexpr int BM = 256, BK = 64, HALF = 128, HTB = HALF * BK * 2  , STAGE_BYTES = 8 * HTB, NXCD = 8, WGM = 8;

__host__ __device__ __forceinline__ int lds_byte(int r, int c) { const int st = (r >> 4) * 2 + (c >> 5), rr = r & 15, cc = c & 31, ob = rr * 64 + cc * 2; return st * 1024 + (ob ^ (((ob >> 9) & 1) << 5)); }
__host__ __device__ __forceinline__ void stage_rc(int b, int& R, int& C) { const int st = b / 1024, sb = b % 1024, swz = sb ^ (((sb >> 9) & 1) << 5); R = (st >> 1) * 16 + swz / 64; C = (st & 1) * 32 + (swz % 64) / 2; }
__host__ __device__ __forceinline__ int perm32(int rho) { const int n = rho >> 4, i = rho & 15; return 8 * (i >> 2) + 4 * n + (i & 3); }

struct Unit { int pm, pn; };
struct Gemm { const bf16_t* A; const bf16_t* Bt; int M, N, K; };

struct StaticOrder {
    int nM, nN, nwg, G, c;
    __host__ __device__ void init(int M, int N, int G_, int c_) { nM = M / BM; nN = N / BM; nwg = nM * nN; G = G_; c = c_; }
    __host__ __device__ bool next(int i, Unit& u) const {
        const long L = (long)i * G + c; if (L >= nwg) return false;
        int wgid = (int)L; { const int q = nwg / NXCD, r = nwg % NXCD, xcd = wgid % NXCD, off = wgid / NXCD; wgid = (xcd < r ? xcd * (q + 1) : r * (q + 1) + (xcd - r) * q) + off; }
        const int nig = WGM * nN, gid = wgid / nig, fm = gid * WGM, gsz = (nM - fm) < WGM ? (nM - fm) : WGM;
        u.pm = fm + ((wgid % nig) % gsz); u.pn = (wgid % nig) / gsz; return true;
    }
    __device__ __forceinline__ void a_ready(const Unit&) const {}
    __device__ __forceinline__ void done(const Unit&) const {}
};

__device__ __forceinline__ unsigned cvt_pk_bf16(float lo, float hi) { unsigned r; asm volatile("v_cvt_pk_bf16_f32 %0, %1, %2" : "=v"(r) : "v"(lo), "v"(hi)); return r; }
typedef float f32x2 __attribute__((ext_vector_type(2)));
typedef unsigned u32x4e __attribute__((ext_vector_type(4)));
constexpr float QK_C2 = 0.125f * 1.4426950408889634f;
constexpr float RMS_EPS = 1e-6f;
struct EpiProj {
    static constexpr bool PERM = true, AFTER_DRAIN = false;
    bf16_t* O; int ldc; const float* rstd;
    __device__ __forceinline__ void operator()(const f32x4 (&acc)[2][2][4][2], const Unit& u, int wr, int wc, int fr, int fq) const {
        const int row0 = u.pm * BM + wr * 64 + fr, col0 = u.pn * BM + wc * 32 + 8 * fq;
        const float cs = (u.pn < 2 || u.pn == 6 || u.pn == 7) ? QK_C2 : 1.f;
#pragma unroll
        for (int ai = 0; ai < 2; ++ai)
#pragma unroll
            for (int m = 0; m < 4; ++m) { const int row = row0 + ai * HALF + m * 16; const float rs = rstd[row] * cs; bf16_t* rowp = O + (size_t)row * ldc + col0;
#pragma unroll
                for (int bj = 0; bj < 2; ++bj) { const f32x4 v0 = acc[ai][bj][m][0] * rs, v1 = acc[ai][bj][m][1] * rs;
                    u32x4e w; w.x = cvt_pk_bf16(v0[0], v0[1]); w.y = cvt_pk_bf16(v0[2], v0[3]); w.z = cvt_pk_bf16(v1[0], v1[1]); w.w = cvt_pk_bf16(v1[2], v1[3]);
                    *(u32x4e*)(rowp + bj * HALF) = w; } }
    }
};
struct EpiRes {
    static constexpr bool PERM = true, AFTER_DRAIN = false;
    const float* X; float* H; bf16_t* HB; float* ssq;
    __device__ __forceinline__ void operator()(const f32x4 (&acc)[2][2][4][2], const Unit& u, int wr, int wc, int fr, int fq) const {
        const int row0 = u.pm * BM + wr * 64 + fr, col0 = u.pn * BM + wc * 32 + 8 * fq;
#pragma unroll
        for (int ai = 0; ai < 2; ++ai)
#pragma unroll
            for (int m = 0; m < 4; ++m) { const int row = row0 + ai * HALF + m * 16; const size_t off = (size_t)row * 1024 + col0; float s = 0.f;
#pragma unroll
                for (int bj = 0; bj < 2; ++bj) {
                    const f32x4 h0 = *(const f32x4*)(X + off + bj * HALF) + acc[ai][bj][m][0], h1 = *(const f32x4*)(X + off + bj * HALF + 4) + acc[ai][bj][m][1];
                    *(f32x4*)(H + off + bj * HALF) = h0; *(f32x4*)(H + off + bj * HALF + 4) = h1;
                    s += (h0[0] * h0[0] + h0[1] * h0[1]) + (h0[2] * h0[2] + h0[3] * h0[3]) + (h1[0] * h1[0] + h1[1] * h1[1]) + (h1[2] * h1[2] + h1[3] * h1[3]);
                    if (HB) { u32x4e w; w.x = cvt_pk_bf16(h0[0], h0[1]); w.y = cvt_pk_bf16(h0[2], h0[3]); w.z = cvt_pk_bf16(h1[0], h1[1]); w.w = cvt_pk_bf16(h1[2], h1[3]);
                        *(u32x4e*)(HB + off + bj * HALF) = w; } }
                s += __shfl_xor(s, 16); s += __shfl_xor(s, 32);
                if (fq == 0) ssq[(size_t)row * 16 + u.pn * 4 + wc] = s; }
    }
};
struct EpiUp {
    static constexpr bool PERM = true, AFTER_DRAIN = false;
    bf16_t* O; int ldc; const float* ssq;
    __device__ __forceinline__ void operator()(const f32x4 (&acc)[2][2][4][2], const Unit& u, int wr, int wc, int fr, int fq) const {
        const int row0 = u.pm * BM + wr * 64 + fr, col0 = u.pn * BM + wc * 32 + 8 * fq;
#pragma unroll
        for (int ai = 0; ai < 2; ++ai)
#pragma unroll
            for (int m = 0; m < 4; ++m) { const int row = row0 + ai * HALF + m * 16; const f32x4* sp = (const f32x4*)(ssq + (size_t)row * 16);
                const f32x4 a = sp[0], b = sp[1], c = sp[2], d = sp[3];
                const float tot = ((a[0] + a[1]) + (a[2] + a[3])) + ((b[0] + b[1]) + (b[2] + b[3])) + ((c[0] + c[1]) + (c[2] + c[3])) + ((d[0] + d[1]) + (d[2] + d[3]));
                const float rs = __builtin_amdgcn_rsqf(tot * (1.0f / 1024.0f) + RMS_EPS); bf16_t* rowp = O + (size_t)row * ldc + col0;
#pragma unroll
                for (int bj = 0; bj < 2; ++bj) { f32x4 v0 = acc[ai][bj][m][0] * rs, v1 = acc[ai][bj][m][1] * rs;
#pragma unroll
                    for (int e = 0; e < 4; ++e) { const float p = fmaxf(v0[e], 0.f), q = fmaxf(v1[e], 0.f); v0[e] = p * p; v1[e] = q * q; }
                    u32x4e w; w.x = cvt_pk_bf16(v0[0], v0[1]); w.y = cvt_pk_bf16(v0[2], v0[3]); w.z = cvt_pk_bf16(v1[0], v1[1]); w.w = cvt_pk_bf16(v1[2], v1[3]);
                    *(u32x4e*)(rowp + bj * HALF) = w; } }
    }
};
template <class Epi, class Sched, bool ALIGN_EPI = false, bool SP2 = false>
__device__ __forceinline__ void gemm_phase(PG8_LAS unsigned char* lds, const Gemm g, const Sched& S, const Epi& E) {
    const int tid = threadIdx.x, wid = __builtin_amdgcn_readfirstlane(tid >> 6), lane = tid & 63, wr = wid >> 2, wc = wid & 3, fr = lane & 15, fq = lane >> 4;
    const int K = g.K, nt = K / BK;
    unsigned voffA[2], voffB[2];
#pragma unroll
    for (int i = 0; i < 2; ++i) { int R, C; stage_rc(tid * 16 + i * 8192, R, C); const int Rb = Epi::PERM ? ((R & ~31) + perm32(R & 31)) : R;
        voffA[i] = (unsigned)(R * K + C) * 2u; voffB[i] = (unsigned)(Rb * K + C) * 2u; }
    const size_t kstep = (size_t)(BK * 2);
    const size_t hstep = (size_t)HALF * K * 2;
    const size_t tstep = 2 * hstep;
    const unsigned ldsw = (unsigned)wid * 1024u;
    const int aoff = lds_byte(wr * 64 + fr, fq * 8), boff = lds_byte(wc * 32 + fr, fq * 8);
#define PG8_SA(b, h) (((b) * 2 + (h)) * HTB)
#define PG8_SB(b, h) ((4 + (b) * 2 + (h)) * HTB)
#define PG8_STAGE(bufoff, gbase, voff) do { _Pragma("unroll") for (int _i = 0; _i < 2; ++_i) \
        __builtin_amdgcn_global_load_lds((const unsigned*)((const char*)(gbase) + (voff)[_i]), (PG8_LAS unsigned*)(lds + (bufoff) + ldsw + _i * 8192), 16, 0, 0); } while (0)
#define PG8_LDA(dst, b, h) do { _Pragma("unroll") for (int m = 0; m < 4; ++m) _Pragma("unroll") for (int k = 0; k < 2; ++k) dst[m][k] = *(const PG8_LAS bf16x8*)(lds + PG8_SA(b, h) + aoff + m * 2048 + k * 1024); } while (0)
#define PG8_LDB(dst, b, h) do { _Pragma("unroll") for (int n = 0; n < 2; ++n) _Pragma("unroll") for (int k = 0; k < 2; ++k) dst[n][k] = *(const PG8_LAS bf16x8*)(lds + PG8_SB(b, h) + boff + n * 2048 + k * 1024); } while (0)
#define PG8_MMA(ai, bj, At, Bt) do { __builtin_amdgcn_s_setprio(1); _Pragma("unroll") for (int m = 0; m < 4; ++m) _Pragma("unroll") for (int n = 0; n < 2; ++n) _Pragma("unroll") for (int k = 0; k < 2; ++k) \
        acc[ai][bj][m][n] = __builtin_amdgcn_mfma_f32_16x16x32_bf16(Bt[n][k], At[m][k], acc[ai][bj][m][n], 0, 0, 0); __builtin_amdgcn_s_setprio(0); } while (0)
#define PG8_WAIT_V(n) asm volatile("s_waitcnt vmcnt(" #n ")" ::: "memory")
#define PG8_WAIT_L(n) asm volatile("s_waitcnt lgkmcnt(" #n ")" ::: "memory")
#define PG8_BAR __builtin_amdgcn_s_barrier()
#define PG8_SCHED __builtin_amdgcn_sched_barrier(0)
    Unit cur, nxt; int ui = 0;
    if (!S.next(0, cur)) return;
    f32x4 acc[2][2][4][2];
#pragma unroll
    for (int a = 0; a < 2; ++a)
#pragma unroll
        for (int b = 0; b < 2; ++b)
#pragma unroll
            for (int m = 0; m < 4; ++m)
#pragma unroll
                for (int n = 0; n < 2; ++n) acc[a][b][m][n] = (f32x4){0.f, 0.f, 0.f, 0.f};
    bf16x8 At[4][2], B0[2][2], B1[2][2];
    const char* cA = (const char*)g.A + (size_t)cur.pm * tstep; const char* cB = (const char*)g.Bt + (size_t)cur.pn * tstep;
    S.a_ready(cur);
    if constexpr (SP2) {
        PG8_STAGE(PG8_SB(0, 0), cB, voffB); PG8_STAGE(PG8_SB(0, 1), cB + hstep, voffB); PG8_STAGE(PG8_SA(0, 0), cA, voffA); PG8_STAGE(PG8_SA(0, 1), cA + hstep, voffA);
        if (wr == 1) PG8_BAR;
        PG8_WAIT_V(2); PG8_BAR;
        PG8_STAGE(PG8_SB(1, 0), cB + kstep, voffB); PG8_STAGE(PG8_SA(1, 0), cA + kstep, voffA); PG8_STAGE(PG8_SB(1, 1), cB + hstep + kstep, voffB);
        PG8_WAIT_V(6); PG8_BAR;
    } else {
        PG8_STAGE(PG8_SB(0, 0), cB, voffB); PG8_STAGE(PG8_SA(0, 0), cA, voffA); PG8_STAGE(PG8_SB(0, 1), cB + hstep, voffB); PG8_STAGE(PG8_SA(0, 1), cA + hstep, voffA);
        if (wr == 1) PG8_BAR;
        PG8_WAIT_V(4); PG8_BAR;
        PG8_STAGE(PG8_SB(1, 0), cB + kstep, voffB); PG8_STAGE(PG8_SA(1, 0), cA + kstep, voffA); PG8_STAGE(PG8_SB(1, 1), cB + hstep + kstep, voffB);
        PG8_WAIT_V(6); PG8_BAR;
    }
    for (;;) {
        const bool has_next = S.next(ui + 1, nxt);
        const char* nA = has_next ? (const char*)g.A + (size_t)nxt.pm * tstep : cA; const char* nB = has_next ? (const char*)g.Bt + (size_t)nxt.pn * tstep : cB;
        for (int t = 0; t < nt; t += 2) {
            const bool last = (t == nt - 2);
            const char* a1 = cA + (size_t)(t + 1) * kstep;
            const char* a2 = last ? nA : cA + (size_t)(t + 2) * kstep; const char* b2 = last ? nB : cB + (size_t)(t + 2) * kstep;
            const char* a3 = a2 + kstep; const char* b3 = b2 + kstep;
            if (last && has_next) S.a_ready(nxt);
            if constexpr (SP2) {
            PG8_LDB(B0, 0, 0); PG8_LDB(B1, 0, 1); PG8_SCHED; PG8_LDA(At, 0, 0); PG8_STAGE(PG8_SA(1, 1), a1 + hstep, voffA);
            PG8_WAIT_V(8); PG8_WAIT_L(0); PG8_BAR; PG8_MMA(0, 0, At, B0); PG8_MMA(0, 1, At, B1); PG8_BAR; PG8_SCHED;
            PG8_LDA(At, 0, 1); PG8_STAGE(PG8_SB(0, 0), b2, voffB); PG8_STAGE(PG8_SB(0, 1), b2 + hstep, voffB); PG8_STAGE(PG8_SA(0, 0), a2, voffA);
            PG8_WAIT_V(8); PG8_WAIT_L(0); PG8_BAR; PG8_MMA(1, 0, At, B0); PG8_MMA(1, 1, At, B1); PG8_BAR; PG8_SCHED;
            PG8_LDB(B0, 1, 0); PG8_LDB(B1, 1, 1); PG8_SCHED; PG8_LDA(At, 1, 0); PG8_STAGE(PG8_SA(0, 1), a2 + hstep, voffA);
            PG8_WAIT_V(8); PG8_WAIT_L(0); PG8_BAR; PG8_MMA(0, 0, At, B0); PG8_MMA(0, 1, At, B1); PG8_BAR; PG8_SCHED;
            PG8_LDA(At, 1, 1); PG8_STAGE(PG8_SB(1, 0), b3, voffB); PG8_STAGE(PG8_SB(1, 1), b3 + hstep, voffB); PG8_STAGE(PG8_SA(1, 0), a3, voffA);
            PG8_WAIT_V(8); PG8_WAIT_L(0); PG8_BAR; PG8_MMA(1, 0, At, B0); PG8_MMA(1, 1, At, B1); PG8_BAR; PG8_SCHED;
            } else {
            PG8_LDB(B0, 0, 0); PG8_SCHED; PG8_LDA(At, 0, 0); PG8_STAGE(PG8_SA(1, 1), a1 + hstep, voffA);
            PG8_WAIT_L(8); PG8_BAR; PG8_WAIT_L(0); PG8_MMA(0, 0, At, B0); PG8_BAR; PG8_SCHED;
            PG8_LDB(B1, 0, 1); PG8_STAGE(PG8_SB(0, 0), b2, voffB);
            PG8_BAR; PG8_WAIT_L(0); PG8_MMA(0, 1, At, B1); PG8_BAR;
            PG8_LDA(At, 0, 1); PG8_STAGE(PG8_SA(0, 0), a2, voffA);
            PG8_BAR; PG8_WAIT_L(0); PG8_MMA(1, 0, At, B0); PG8_BAR; PG8_SCHED;
            PG8_STAGE(PG8_SB(0, 1), b2 + hstep, voffB);
            PG8_WAIT_V(6); PG8_BAR; PG8_MMA(1, 1, At, B1); PG8_BAR;
            PG8_LDB(B0, 1, 0); PG8_SCHED; PG8_LDA(At, 1, 0); PG8_STAGE(PG8_SA(0, 1), a2 + hstep, voffA);
            PG8_WAIT_L(8); PG8_BAR; PG8_WAIT_L(0); PG8_MMA(0, 0, At, B0); PG8_BAR; PG8_SCHED;
            PG8_LDB(B1, 1, 1); PG8_STAGE(PG8_SB(1, 0), b3, voffB);
            PG8_BAR; PG8_WAIT_L(0); PG8_MMA(0, 1, At, B1); PG8_BAR;
            PG8_LDA(At, 1, 1); PG8_STAGE(PG8_SA(1, 0), a3, voffA);
            PG8_BAR; PG8_WAIT_L(0); PG8_MMA(1, 0, At, B0); PG8_BAR; PG8_SCHED;
            PG8_STAGE(PG8_SB(1, 1), b3 + hstep, voffB);
            PG8_WAIT_V(6); PG8_BAR; PG8_MMA(1, 1, At, B1); PG8_BAR;
            }
        }
        if constexpr (ALIGN_EPI) { if (wr == 0) PG8_BAR; }
        if constexpr (!Epi::AFTER_DRAIN) { E(acc, cur, wr, wc, fr, fq); S.done(cur); }
        if (!has_next) break;
#pragma unroll
        for (int a = 0; a < 2; ++a)
#pragma unroll
            for (int b = 0; b < 2; ++b)
#pragma unroll
                for (int m = 0; m < 4; ++m)
#pragma unroll
                    for (int n = 0; n < 2; ++n) acc[a][b][m][n] = (f32x4){0.f, 0.f, 0.f, 0.f};
        cur = nxt; cA = nA; cB = nB; ++ui;
        if constexpr (ALIGN_EPI) { if (wr == 1) PG8_BAR; }
    }
    PG8_WAIT_V(0);
    if constexpr (!ALIGN_EPI) { if (wr == 0) PG8_BAR; }
    PG8_BAR;
    if constexpr (Epi::AFTER_DRAIN) { E.fused(acc, cur, wr, wc, fr, fq, lds, wid, lane); S.done(cur); }
#undef PG8_SA
#undef PG8_SB
#undef PG8_STAGE
#undef PG8_LDA
#undef PG8_LDB
#undef PG8_MMA
#undef PG8_WAIT_V
#undef PG8_WAIT_L
#undef PG8_BAR
#undef PG8_SCHED
}
}
namespace att {
#define ATT_LAS __attribute__((address_space(3)))
typedef unsigned short bf16_t;
typedef short bf16x8 __attribute__((ext_vector_type(8)));
typedef _Float16 f16x8 __attribute__((ext_vector_type(8)));
typedef _Float16 f16x2 __attribute__((ext_vector_type(2)));
typedef float f32x16 __attribute__((ext_vector_type(16)));
typedef float f32x4 __attribute__((ext_vector_type(4)));
typedef float f32x2 __attribute__((ext_vector_type(2)));
typedef __bf16 bf16x2_t __attribute__((ext_vector_type(2)));
typedef short s16x4 __attribute__((ext_vector_type(4)));
typedef short v4i16_t __attribute__((ext_vector_type(4)));
typedef unsigned u32x4 __attribute__((ext_vector_type(4)));
typedef unsigned u32x2 __attribute__((ext_vector_type(2)));
typedef ATT_LAS unsigned char* ldsp;
typedef ATT_LAS const unsigned char* cldsp;

constexpr int SEQ = 2048, PITCH = 3072, MIXP = 1024, SLOTB = 32768;
constexpr float LOG2E = 1.4426950408889634f;
constexpr float THR = 8.0f;
constexpr float SB_DONE = 150.0f;

__device__ __forceinline__ int crow(int r, int hi) { return (r & 3) + 8 * (r >> 2) + 4 * hi; }
__device__ __forceinline__ unsigned pk_bf16(float lo, float hi) { f32x2 v = {lo, hi}; return __builtin_bit_cast(unsigned, __builtin_convertvector(v, bf16x2_t)); }
__device__ __forceinline__ unsigned pk_f16(float lo, float hi) { f32x2 v = {lo, hi}; return __builtin_bit_cast(unsigned, __builtin_convertvector(v, f16x2)); }
__device__ __forceinline__ void dma16(const void* g, ldsp l) { __builtin_amdgcn_global_load_lds((const unsigned*)g, (ATT_LAS unsigned*)l, 16, 0, 0); }
__device__ __forceinline__ s16x4 vtr(cldsp p) { return __builtin_bit_cast(s16x4, __builtin_amdgcn_ds_read_tr16_b64_v4i16((ATT_LAS v4i16_t*)p)); }
__device__ __forceinline__ float pmax32(float v) { auto rr = __builtin_amdgcn_permlane32_swap(__float_as_uint(v), __float_as_uint(v), false, false); return fmaxf(__uint_as_float(rr[0]), __uint_as_float(rr[1])); }
__device__ __forceinline__ float psum32(float v) { auto rr = __builtin_amdgcn_permlane32_swap(__float_as_uint(v), __float_as_uint(v), false, false); return __uint_as_float(rr[0]) + __uint_as_float(rr[1]); }
__device__ __forceinline__ bf16x8 packbf(const f32x16& p, int b) { u32x4 w; w.x = pk_bf16(p[b], p[b + 1]); w.y = pk_bf16(p[b + 2], p[b + 3]); w.z = pk_bf16(p[b + 4], p[b + 5]); w.w = pk_bf16(p[b + 6], p[b + 7]); return __builtin_bit_cast(bf16x8, w); }
__device__ __forceinline__ f16x8 packh(const f32x16& p, int b) { u32x4 w; w.x = pk_f16(p[b], p[b + 1]); w.y = pk_f16(p[b + 2], p[b + 3]); w.z = pk_f16(p[b + 4], p[b + 5]); w.w = pk_f16(p[b + 6], p[b + 7]); return __builtin_bit_cast(f16x8, w); }

__device__ __forceinline__ void qkt(f32x16& s0, f32x16& s1, cldsp Ks, const bf16x8* qf, const f32x16& c0, const f32x16& c1, int r32, int hi) {
    cldsp kb = Ks + hi * 1024 + r32 * 16;
    s0 = c0; s1 = c1;
#pragma unroll
    for (int d0 = 0; d0 < 4; ++d0) {
        const bf16x8 b0 = *(ATT_LAS const bf16x8*)(kb + d0 * 2048);
        const bf16x8 b1 = *(ATT_LAS const bf16x8*)(kb + d0 * 2048 + 512);
        s0 = __builtin_amdgcn_mfma_f32_32x32x16_bf16(b0, qf[d0], s0, 0, 0, 0);
        s1 = __builtin_amdgcn_mfma_f32_32x32x16_bf16(b1, qf[d0], s1, 0, 0, 0);
    }
}
template <int NE> __device__ __forceinline__ void pv(f32x16* o, cldsp Vs, int vb, const bf16x8* pf) {
#pragma unroll
    for (int eb = 0; eb < NE; ++eb)
#pragma unroll
        for (int ks = 0; ks < 4; ++ks) {
            const s16x4 lo = vtr(Vs + vb + eb * 4096 + ks * 1024), hh = vtr(Vs + vb + eb * 4096 + ks * 1024 + 512);
            const bf16x8 a = {lo[0], lo[1], lo[2], lo[3], hh[0], hh[1], hh[2], hh[3]};
            o[eb] = __builtin_amdgcn_mfma_f32_32x32x16_bf16(a, pf[ks], o[eb], 0, 0, 0);
        }
}
#define ATT_WAIT_BAR() do { asm volatile("s_waitcnt vmcnt(0) lgkmcnt(0)" ::: "memory"); __syncthreads(); } while (0)

__device__ __forceinline__ void diff_unit(int b, int h, int qb, const bf16_t* proj, bf16_t* mixed, ldsp lds, float lam, const float* subln_g) {
    const int tid = threadIdx.x, lane = tid & 63, r32 = lane & 31, hi = lane >> 5;
    const int wid = __builtin_amdgcn_readfirstlane(tid >> 6), pr = wid & 3, mp = wid >> 2;
    const int q0 = qb * 128, c0 = q0 >> 6, cw = c0 + (pr >> 1), R0 = q0 + 32 * pr;
    const size_t rowbase = (size_t)b * SEQ;
    const float slope2 = exp2f(-2.0f * (float)(h + 1)) * LOG2E;
    const bf16_t* Qw = proj + (rowbase + R0 + r32) * PITCH + h * 128 + mp * 64 + hi * 8;
    bf16x8 qf[4];
#pragma unroll
    for (int d0 = 0; d0 < 4; ++d0) qf[d0] = *(const bf16x8*)(Qw + d0 * 16);
    const bf16_t* ksrc = proj + (rowbase + lane) * PITCH + 512 + h * 128 + wid * 8;
    const bf16_t* vsrc = proj + (rowbase + (2 * (wid & 1)) * 16 + (lane >> 2)) * PITCH + 1024 + h * 128 + (wid >> 1) * 32 + (lane & 3) * 8;
    const int vdst = 16384 + (wid >> 1) * 4096 + (2 * (wid & 1)) * 1024;
    const int vb = (4 * hi + ((lane & 15) >> 2)) * 64 + ((lane >> 4) & 1) * 32 + (lane & 3) * 8;
#define DF_ISSUE(j, slot) do { ldsp sb_ = lds + (slot) * SLOTB; const size_t to_ = (size_t)(j) * 64 * PITCH; \
        dma16(ksrc + to_, sb_ + wid * 1024); dma16(ksrc + to_ + 64, sb_ + 8192 + wid * 1024); \
        dma16(vsrc + to_, sb_ + vdst); dma16(vsrc + to_ + 16 * PITCH, sb_ + vdst + 1024); } while (0)
    f32x16 o[4];
#pragma unroll
    for (int e = 0; e < 4; ++e) o[e] = f32x16{};
    float mref = 0.f, l = 0.f;
    const float tq = (float)(R0 + r32);
    DF_ISSUE(c0 + 1, 0);
    int it = 0;
    for (int j = c0 + 1; j >= 0; --j, ++it) {
        ATT_WAIT_BAR();
        if (j > 0) DF_ISSUE(j - 1, (it + 1) & 1);
        if (j <= cw) {
            cldsp sb = lds + (it & 1) * SLOTB;
            f32x16 cv0, cv1;
            if (j == cw) { const float trel = tq - (float)(64 * cw);
#pragma unroll
                for (int r = 0; r < 16; ++r) { const float kk = (float)crow(r, hi); cv0[r] = -slope2 * fabsf(kk - trel) - mref; cv1[r] = -slope2 * fabsf(kk + 32.f - trel) - mref; }
            } else { const float base = slope2 * ((float)(64 * j + 4 * hi) - tq) - mref;
#pragma unroll
                for (int r = 0; r < 16; ++r) { const float cr = (float)((r & 3) + 8 * (r >> 2)); cv0[r] = fmaf(slope2, cr, base); cv1[r] = fmaf(slope2, cr + 32.f, base); }
            }
            f32x16 s0, s1; qkt(s0, s1, sb + mp * 8192, qf, cv0, cv1, r32, hi);
            float rm = fmaxf(s0[0], s1[0]);
#pragma unroll
            for (int r = 1; r < 16; ++r) rm = fmaxf(rm, fmaxf(s0[r], s1[r]));
            rm = pmax32(rm);
            const bool first = (j == cw);
            if (first || __any(rm > THR)) {
                const float dl = first ? rm : fmaxf(rm, 0.f); mref += dl;
#pragma unroll
                for (int r = 0; r < 16; ++r) { s0[r] -= dl; s1[r] -= dl; }
                if (!first) { const float f = __builtin_amdgcn_exp2f(-dl); l *= f;
#pragma unroll
                    for (int e = 0; e < 4; ++e)
#pragma unroll
                        for (int r = 0; r < 16; ++r) o[e][r] *= f; }
            }
            float sa = 0.f, sb2 = 0.f;
#pragma unroll
            for (int r = 0; r < 16; ++r) { s0[r] = __builtin_amdgcn_exp2f(s0[r]); s1[r] = __builtin_amdgcn_exp2f(s1[r]); sa += s0[r]; sb2 += s1[r]; }
            l += sa + sb2;
            bf16x8 pf[4]; pf[0] = packbf(s0, 0); pf[1] = packbf(s0, 8); pf[2] = packbf(s1, 0); pf[3] = packbf(s1, 8);
            pv<4>(o, sb + 16384, vb, pf);
        }
    }
    ATT_WAIT_BAR();
    l = psum32(l); const float inv = 1.0f / l;
    ATT_LAS float* xch = (ATT_LAS float*)lds + pr * 4096;
    if (mp == 1) {
#pragma unroll
        for (int e = 0; e < 4; ++e)
#pragma unroll
            for (int r = 0; r < 16; ++r) xch[(e * 16 + r) * 64 + lane] = o[e][r] * inv;
    }
    ATT_WAIT_BAR();
    if (mp == 0) {
        float ss = 0.f;
#pragma unroll
        for (int e = 0; e < 4; ++e)
#pragma unroll
            for (int r = 0; r < 16; ++r) { const float v = o[e][r] * inv - lam * xch[(e * 16 + r) * 64 + lane]; o[e][r] = v; ss += v * v; }
        ss = psum32(ss);
        const float rs = __builtin_amdgcn_rsqf(ss * (1.0f / 128.0f) + 1e-6f) * 0.8f;
        bf16_t* orow = mixed + (rowbase + R0 + r32) * MIXP + h * 128 + 4 * hi;
#pragma unroll
        for (int e = 0; e < 4; ++e)
#pragma unroll
            for (int g = 0; g < 4; ++g) { const f32x4 gg = *(const f32x4*)(subln_g + e * 32 + 8 * g + 4 * hi);
                u32x2 w; w.x = pk_bf16(o[e][4 * g] * rs * gg[0], o[e][4 * g + 1] * rs * gg[1]); w.y = pk_bf16(o[e][4 * g + 2] * rs * gg[2], o[e][4 * g + 3] * rs * gg[3]);
                *(u32x2*)(orow + e * 32 + 8 * g) = w; }
    }
    ATT_WAIT_BAR();
#undef DF_ISSUE
}

__device__ __forceinline__ void sb_unit(int b, int hp, int qb, const bf16_t* proj, bf16_t* mixed, ldsp lds, const float* sb_g, ATT_LAS unsigned* flags) {
    const int tid = threadIdx.x, lane = tid & 63, r32 = lane & 31, hi = lane >> 5;
    const int wid = __builtin_amdgcn_readfirstlane(tid >> 6), pr = wid & 3, hs = wid >> 2, head = 2 * hp + hs;
    const int q0 = qb * 128, c0 = q0 >> 6, cw = c0 + (pr >> 1), R0 = q0 + 32 * pr;
    const size_t rowbase = (size_t)b * SEQ;
    const bf16_t* Qw = proj + (rowbase + R0 + r32) * PITCH + 1536 + head * 64 + hi * 8;
    bf16x8 qf[4];
#pragma unroll
    for (int d0 = 0; d0 < 4; ++d0) qf[d0] = *(const bf16x8*)(Qw + d0 * 16);
    const bf16_t* ksrc = proj + (rowbase + lane) * PITCH + 2048 + (2 * hp) * 64 + wid * 8;
    const bf16_t* vsrc = proj + (rowbase + (wid & 3) * 16 + (lane >> 2)) * PITCH + 2560 + (2 * hp) * 64 + (wid >> 2) * 32 + (lane & 3) * 8;
    const int vdst = 16384 + (wid >> 2) * 4096 + (wid & 3) * 1024;
    const int vb = (4 * hi + ((lane & 15) >> 2)) * 64 + ((lane >> 4) & 1) * 32 + (lane & 3) * 8;
#define SB_ISSUE(j, slot) do { ldsp sb_ = lds + (slot) * SLOTB; const size_t to_ = (size_t)(j) * 64 * PITCH; \
        dma16(ksrc + to_, sb_ + wid * 1024); dma16(ksrc + to_ + 64, sb_ + 8192 + wid * 1024); \
        dma16(vsrc + to_, sb_ + vdst); dma16(vsrc + to_ + 64, sb_ + vdst + 8192); } while (0)
    f16x8 tri[2], ones;
#pragma unroll
    for (int s = 0; s < 2; ++s)
#pragma unroll
        for (int jj = 0; jj < 8; ++jj) { const int key = 16 * s + 8 * (jj >> 2) + 4 * hi + (jj & 3); tri[s][jj] = (key >= r32) ? (_Float16)1.0f : (_Float16)0.0f; }
#pragma unroll
    for (int jj = 0; jj < 8; ++jj) ones[jj] = (_Float16)1.0f;
    f32x16 o[2]; o[0] = f32x16{}; o[1] = f32x16{};
    f32x16 carry = f32x16{};
    bool wdone = false;
    SB_ISSUE(c0 + 1, 0);
    int it = 0;
    for (int j = c0 + 1; j >= 0; --j, ++it) {
        if (lane == 0) flags[(it & 1) * 8 + wid] = wdone ? 1u : 0u;
        ATT_WAIT_BAR();
        { const u32x4 fa = *(ATT_LAS const u32x4*)(flags + (it & 1) * 8), fb = *(ATT_LAS const u32x4*)(flags + (it & 1) * 8 + 4);
          if ((fa.x & fa.y & fa.z & fa.w & fb.x & fb.y & fb.z & fb.w) != 0u) break; }
        if (j > 0) SB_ISSUE(j - 1, (it + 1) & 1);
        if (j <= cw && !wdone) {
            cldsp sb = lds + (it & 1) * SLOTB;
            f32x16 z0, z1; { const f32x16 zz = f32x16{}; qkt(z0, z1, sb + hs * 8192, qf, zz, zz, r32, hi); }
            if (j == cw) { const int trel = R0 + r32 - 64 * j;
#pragma unroll
                for (int r = 0; r < 16; ++r) { const int kk = crow(r, hi); if (kk >= trel) z0[r] = -1e30f; if (kk + 32 >= trel) z1[r] = -1e30f; }
            }
            f32x16 p0, p1;
#pragma unroll
            for (int r = 0; r < 16; ++r) { z0[r] = fminf(z0[r], 60.f); z1[r] = fminf(z1[r], 60.f);
                p0[r] = __builtin_amdgcn_logf(1.0f + __builtin_amdgcn_exp2f(z0[r])); p1[r] = __builtin_amdgcn_logf(1.0f + __builtin_amdgcn_exp2f(z1[r])); }
            f16x8 sf[4]; sf[0] = packh(p0, 0); sf[1] = packh(p0, 8); sf[2] = packh(p1, 0); sf[3] = packh(p1, 8);
            f32x16 t1 = __builtin_amdgcn_mfma_f32_32x32x16_f16(ones, sf[2], carry, 0, 0, 0); t1 = __builtin_amdgcn_mfma_f32_32x32x16_f16(ones, sf[3], t1, 0, 0, 0);
            f32x16 i1 = __builtin_amdgcn_mfma_f32_32x32x16_f16(tri[0], sf[2], carry, 0, 0, 0); i1 = __builtin_amdgcn_mfma_f32_32x32x16_f16(tri[1], sf[3], i1, 0, 0, 0);
            f32x16 i0 = __builtin_amdgcn_mfma_f32_32x32x16_f16(tri[0], sf[0], t1, 0, 0, 0); i0 = __builtin_amdgcn_mfma_f32_32x32x16_f16(tri[1], sf[1], i0, 0, 0, 0);
            carry = __builtin_amdgcn_mfma_f32_32x32x16_f16(ones, sf[0], t1, 0, 0, 0); carry = __builtin_amdgcn_mfma_f32_32x32x16_f16(ones, sf[1], carry, 0, 0, 0);
#pragma unroll
            for (int r = 0; r < 16; ++r) { z0[r] = __builtin_amdgcn_exp2f(z0[r] - i0[r]); z1[r] = __builtin_amdgcn_exp2f(z1[r] - i1[r]); }
            bf16x8 pf[4]; pf[0] = packbf(z0, 0); pf[1] = packbf(z0, 8); pf[2] = packbf(z1, 0); pf[3] = packbf(z1, 8);
            pv<2>(o, sb + 16384 + hs * 8192, vb, pf);
            wdone = !__any(carry[0] < SB_DONE);
        }
    }
    {
        float ss = 0.f;
#pragma unroll
        for (int e = 0; e < 2; ++e)
#pragma unroll
            for (int r = 0; r < 16; ++r) ss += o[e][r] * o[e][r];
        ss = psum32(ss);
        const float rs = __builtin_amdgcn_rsqf(ss * (1.0f / 64.0f) + 1e-6f);
        bf16_t* orow = mixed + (rowbase + R0 + r32) * MIXP + 512 + head * 64 + 4 * hi;
#pragma unroll
        for (int e = 0; e < 2; ++e)
#pragma unroll
            for (int g = 0; g < 4; ++g) { const f32x4 gg = *(const f32x4*)(sb_g + e * 32 + 8 * g + 4 * hi);
                u32x2 w; w.x = pk_bf16(o[e][4 * g] * rs * gg[0], o[e][4 * g + 1] * rs * gg[1]); w.y = pk_bf16(o[e][4 * g + 2] * rs * gg[2], o[e][4 * g + 3] * rs * gg[3]);
                *(u32x2*)(orow + e * 32 + 8 * g) = w; }
    }
    ATT_WAIT_BAR();
#undef SB_ISSUE
}
}
#ifndef MK_N_LAUNCHES
#define MK_N_LAUNCHES 1
#endif
constexpr int N_PHASES = 7;
constexpr int M_ = 16384, D_ = 1024, NIN = 3072, FF_ = 4096, SEQ_ = 2048;
constexpr size_t MiB = 1u << 20;
constexpr size_t WS_WIN = 2 * MiB, WS_WOUT = 8 * MiB, WS_WUP = 10 * MiB, WS_WDN = 18 * MiB;
constexpr size_t WS_RSTD1 = 26 * MiB, WS_SSQ2 = 27 * MiB, WS_SSQ3 = 28 * MiB;
constexpr size_t WS_XB = 32 * MiB;
constexpr size_t WS_PROJ = 64 * MiB;
constexpr size_t WS_MIX = 160 * MiB;
constexpr size_t WS_U = 64 * MiB;
constexpr size_t WS_END = 192 * MiB;
constexpr int LDS_BYTES = 147456, FLAGS_OFF = 131072 + 512;
#define LAS __attribute__((address_space(3)))
#define GAS __attribute__((address_space(1)))
typedef unsigned short bf16;
typedef unsigned v4u __attribute__((ext_vector_type(4)));
typedef float f32x4 __attribute__((ext_vector_type(4)));
#define LDS_WAIT() asm volatile("s_waitcnt lgkmcnt(0)" ::: "memory")
__device__ __forceinline__ unsigned f2bf(float f) { unsigned u = __builtin_bit_cast(unsigned, f); return (u + 0x7fffu + ((u >> 16) & 1u)) >> 16; }
__device__ __forceinline__ unsigned pk2(float lo, float hi) { return f2bf(lo) | (f2bf(hi) << 16); }
__device__ __forceinline__ float wave_sum(float v) {
#pragma unroll
    for (int o = 1; o < 64; o <<= 1) v += __shfl_xor(v, o);
    return v;
}
__device__ __forceinline__ void p0_transpose_item(const float* W, const float* g, int K, int N, bf16* WT, LAS float* scr, int item, int lane) {
    const int nblk = N / 32, kb = item / nblk, nb = item % nblk, k0 = 64 * kb, n0 = 32 * nb;
#pragma unroll 8
    for (int i = 0; i < 32; ++i) { const int kk = 2 * i + (lane >> 5); const float gs = g ? g[k0 + kk] : 1.0f; scr[kk * 33 + (lane & 31)] = W[(size_t)(k0 + kk) * N + n0 + (lane & 31)] * gs; }
    LDS_WAIT(); asm volatile("" ::: "memory");
    const int c = lane & 7;
#pragma unroll
    for (int j = 0; j < 4; ++j) { const int n = (lane >> 3) + 8 * j; const LAS float* s = scr + (8 * c) * 33 + n;
        v4u o; o.x = pk2(s[0 * 33], s[1 * 33]); o.y = pk2(s[2 * 33], s[3 * 33]); o.z = pk2(s[4 * 33], s[5 * 33]); o.w = pk2(s[6 * 33], s[7 * 33]);
        *(GAS v4u*)(WT + (size_t)(n0 + n) * K + k0 + 8 * c) = o; }
    LDS_WAIT(); asm volatile("" ::: "memory");
}

struct Args { const float* in[14]; float* out; unsigned char* ws; int ph_lo, ph_hi; };
__global__ void __launch_bounds__(512, 2) fwd_kernel(Args args) {
    extern __shared__ __attribute__((aligned(16))) unsigned char lds_raw[];
    LAS unsigned char* lds = (LAS unsigned char*)lds_raw;
    const int tid = threadIdx.x, lane = tid & 63, wave = __builtin_amdgcn_readfirstlane(tid >> 6);
    const int G = gridDim.x, blk = blockIdx.x;
    unsigned char* ws = args.ws;
    const float* x = args.in[0]; const float* norm1_g = args.in[1]; const float* w_in = args.in[2];
    const float* lq1 = args.in[3]; const float* lk1 = args.in[4]; const float* lq2 = args.in[5]; const float* lk2 = args.in[6];
    const float* subln_g = args.in[7]; const float* sb_g = args.in[8]; const float* w_out = args.in[9]; const float* norm2_g = args.in[10];
    const float* w_up = args.in[11]; const float* w_down = args.in[12]; const float* fin_g = args.in[13];
    float* out = args.out;
    bf16* WinT = (bf16*)(ws + WS_WIN); bf16* WoutT = (bf16*)(ws + WS_WOUT); bf16* WupT = (bf16*)(ws + WS_WUP); bf16* WdnT = (bf16*)(ws + WS_WDN);
    float* rstd1 = (float*)(ws + WS_RSTD1); float* ssq2 = (float*)(ws + WS_SSQ2); float* ssq3 = (float*)(ws + WS_SSQ3);
    bf16* XB = (bf16*)(ws + WS_XB); bf16* PROJ = (bf16*)(ws + WS_PROJ); bf16* MIX = (bf16*)(ws + WS_MIX); bf16* UB = (bf16*)(ws + WS_U);
    const int lo = args.ph_lo, hi = args.ph_hi;
#define IN(k) (lo <= (k) && (k) < hi)
#define SEAM(k) do { if (IN(k) && IN((k) + 1)) cg::this_grid().sync(); } while (0)

    if (IN(0)) {
        LAS float* scr = (LAS float*)(lds + wave * 16384);
        const int gw = blk * 8 + wave, NGW = G * 8;
        constexpr int I_IN = (D_ / 64) * (NIN / 32), I_O = (D_ / 64) * (D_ / 32), I_UP = (D_ / 64) * (FF_ / 32), I_DN = (FF_ / 64) * (D_ / 32);
        for (int it = gw; it < I_IN + I_O + I_UP + I_DN; it += NGW) {
            int r = it;
            if (r < I_IN) { p0_transpose_item(w_in, norm1_g, D_, NIN, WinT, scr, r, lane); continue; } r -= I_IN;
            if (r < I_O) { p0_transpose_item(w_out, nullptr, D_, D_, WoutT, scr, r, lane); continue; } r -= I_O;
            if (r < I_UP) { p0_transpose_item(w_up, norm2_g, D_, FF_, WupT, scr, r, lane); continue; } r -= I_UP;
            p0_transpose_item(w_down, nullptr, FF_, D_, WdnT, scr, r, lane);
        }
        for (int m = gw; m < M_; m += NGW) {
            const GAS f32x4* xr = (const GAS f32x4*)(x + (size_t)m * D_) + lane;
            f32x4 v[4]; float s = 0.f;
#pragma unroll
            for (int j = 0; j < 4; ++j) { v[j] = xr[64 * j]; s += (v[j].x * v[j].x + v[j].y * v[j].y) + (v[j].z * v[j].z + v[j].w * v[j].w); }
            s = wave_sum(s);
            if (lane == 0) rstd1[m] = __builtin_amdgcn_rsqf(s * (1.0f / D_) + 1e-6f);
            GAS unsigned long long* o8 = (GAS unsigned long long*)(XB + (size_t)m * D_) + lane;
#pragma unroll
            for (int j = 0; j < 4; ++j) o8[64 * j] = (unsigned long long)pk2(v[j].x, v[j].y) | ((unsigned long long)pk2(v[j].z, v[j].w) << 32);
        }
    }
    SEAM(0);
    if (IN(1)) {
        pg8::Gemm g{XB, WinT, M_, NIN, D_}; pg8::StaticOrder S; S.init(M_, NIN, G, blk);
        pg8::EpiProj E{PROJ, NIN, rstd1};
        pg8::gemm_phase<pg8::EpiProj, pg8::StaticOrder, true, true>(lds, g, S, E);
    }
    SEAM(1);
    if (IN(2)) {
        float d1 = lq1[lane] * lk1[lane], d2 = lq2[lane] * lk2[lane];
        d1 = wave_sum(d1); d2 = wave_sum(d2);
        const float lam = expf(d1) - expf(d2) + 0.2f;
        LAS unsigned* flags = (LAS unsigned*)(lds + FLAGS_OFF);
        for (int n = blk; n < 1024; n += G) {
            int idx = n; if ((n >> 8) & 1) idx = (n & ~255) + 255 - (n & 255);
            const int v = idx & 511, qb = 15 - (v >> 5), rem = v & 31, b = rem >> 2, hh = rem & 3;
            if (idx < 512) att::diff_unit(b, hh, qb, PROJ, MIX, lds, lam, subln_g);
            else att::sb_unit(b, hh, qb, PROJ, MIX, lds, sb_g, flags);
        }
    }
    SEAM(2);
    if (IN(3)) {
        pg8::Gemm g{MIX, WoutT, M_, D_, D_}; pg8::StaticOrder S; S.init(M_, D_, G, blk);
        pg8::EpiRes E{x, out, XB, ssq2};
        pg8::gemm_phase<pg8::EpiRes, pg8::StaticOrder, true, true>(lds, g, S, E);
    }
    SEAM(3);
    if (IN(4)) {
        pg8::Gemm g{XB, WupT, M_, FF_, D_}; pg8::StaticOrder S; S.init(M_, FF_, G, blk);
        pg8::EpiUp E{UB, FF_, ssq2};
        pg8::gemm_phase<pg8::EpiUp, pg8::StaticOrder, true, true>(lds, g, S, E);
    }
    SEAM(4);
    if (IN(5)) {
        pg8::Gemm g{UB, WdnT, M_, D_, FF_}; pg8::StaticOrder S; S.init(M_, D_, G, blk);
        pg8::EpiRes E{out, out, nullptr, ssq3};
        pg8::gemm_phase<pg8::EpiRes, pg8::StaticOrder, true, true>(lds, g, S, E);
    }
    SEAM(5);
    if (IN(6)) {
        const int gw = blk * 8 + wave, NGW = G * 8;
        f32x4 gf[4];
#pragma unroll
        for (int j = 0; j < 4; ++j) gf[j] = ((const f32x4*)fin_g)[lane + 64 * j];
        for (int m = gw; m < M_; m += NGW) {
            float s = (lane < 16) ? ssq3[(size_t)m * 16 + lane] : 0.f;
            s = wave_sum(s);
            const float rs = __builtin_amdgcn_rsqf(s * (1.0f / D_) + 1e-6f);
            GAS f32x4* orow = (GAS f32x4*)(out + (size_t)m * D_) + lane;
#pragma unroll
            for (int j = 0; j < 4; ++j) { const f32x4 v = orow[64 * j]; orow[64 * j] = v * rs * gf[j]; }
        }
    }
#undef IN
#undef SEAM
}

extern "C" void kernel_launch(void* const* d_in, const int* in_sizes, int n_in, void* d_out, int out_size, void* d_ws, size_t ws_size, hipStream_t stream) {
    static int grid = 0;
    if (grid == 0) {
        if (n_in != 14 || in_sizes[0] != M_ * D_ || out_size != M_ * D_ || ws_size < WS_END) { fprintf(stderr, "kernel_launch: unexpected shapes (n_in %d, in0 %d, out %d, ws %zu)\n", n_in, n_in > 0 ? in_sizes[0] : -1, out_size, ws_size); grid = -1; return; }
        int dev = 0, cus = 0, per_cu = 0;
        if (hipGetDevice(&dev) != hipSuccess || hipDeviceGetAttribute(&cus, hipDeviceAttributeMultiprocessorCount, dev) != hipSuccess) { grid = -1; return; }
        if (hipFuncSetAttribute((const void*)fwd_kernel, hipFuncAttributeMaxDynamicSharedMemorySize, LDS_BYTES) != hipSuccess) { fprintf(stderr, "kernel_launch: hipFuncSetAttribute failed\n"); grid = -1; return; }
        if (hipOccupancyMaxActiveBlocksPerMultiprocessor(&per_cu, (const void*)fwd_kernel, 512, LDS_BYTES) != hipSuccess || per_cu < 1) per_cu = 1;
        (void)hipGetLastError();
        grid = cus * per_cu;
    }
    if (grid < 0) return;
    Args a{};
    for (int i = 0; i < 14; ++i) a.in[i] = (const float*)d_in[i];
    a.out = (float*)d_out; a.ws = (unsigned char*)d_ws;
#if MK_N_LAUNCHES == 1
    a.ph_lo = 0; a.ph_hi = N_PHASES;
    void* kargs[] = {&a};
    hipError_t e = hipLaunchCooperativeKernel((const void*)fwd_kernel, dim3(grid), dim3(512), kargs, LDS_BYTES, stream);
    if (e != hipSuccess) fprintf(stderr, "kernel_launch: cooperative launch failed: %s (grid %d)\n", hipGetErrorString(e), grid);
#else
    for (int p = 0; p < N_PHASES; ++p) { a.ph_lo = p; a.ph_hi = p + 1; hipLaunchKernelGGL(fwd_kernel, dim3(grid), dim3(512), LDS_BYTES, stream, a); }
#endif
}
```

```cpp
#include <hip/hip_runtime.h>
#include <hip/hip_cooperative_groups.h>
#include <cstdio>
#include <cstdint>
namespace cg = cooperative_groups;
#define MK_N_LAUNCHES 1
namespace pg8 {
#define PG8_LAS __attribute__((address_space(3)))
typedef unsigned short bf16_t;
typedef short bf16x8 __attribute__((ext_vector_type(8)));
typedef float f32x4 __attribute__((ext_vector_type(4)));
typedef unsigned u32x4 __attribute__((ext_vector_type(4)));
constexpr int BM = 256, BK = 64, HALF = 128, HTB = HALF * BK * 2  , STAGE_BYTES = 8 * HTB, NXCD = 8, WGM = 8;

__host__ __device__ __forceinline__ int lds_byte(int r, int c) { const int st = (r >> 4) * 2 + (c >> 5), rr = r & 15, cc = c & 31, ob = rr * 64 + cc * 2; return st * 1024 + (ob ^ (((ob >> 9) & 1) << 5)); }
__host__ __device__ __forceinline__ void stage_rc(int b, int& R, int& C) { const int st = b / 1024, sb = b % 1024, swz = sb ^ (((sb >> 9) & 1) << 5); R = (st >> 1) * 16 + swz / 64; C = (st & 1) * 32 + (swz % 64) / 2; }
__host__ __device__ __forceinline__ int perm32(int rho) { const int n = rho >> 4, i = rho & 15; return 8 * (i >> 2) + 4 * n + (i & 3); }

struct Unit { int pm, pn; };
struct Gemm { const bf16_t* A; const bf16_t* Bt; int M, N, K; };

struct StaticOrder {
    int nM, nN, nwg, G, c;
    __host__ __device__ void init(int M, int N, int G_, int c_) { nM = M / BM; nN = N / BM; nwg = nM * nN; G = G_; c = c_; }
    __host__ __device__ bool next(int i, Unit& u) const {
        const long L = (long)i * G + c; if (L >= nwg) return false;
        int wgid = (int)L; { const int q = nwg / NXCD, r = nwg % NXCD, xcd = wgid % NXCD, off = wgid / NXCD; wgid = (xcd < r ? xcd * (q + 1) : r * (q + 1) + (xcd - r) * q) + off; }
        const int nig = WGM * nN, gid = wgid / nig, fm = gid * WGM, gsz = (nM - fm) < WGM ? (nM - fm) : WGM;
        u.pm = fm + ((wgid % nig) % gsz); u.pn = (wgid % nig) / gsz; return true;
    }
    __device__ __forceinline__ void a_ready(const Unit&) const {}
    __device__ __forceinline__ void done(const Unit&) const {}
};

__device__ __forceinline__ unsigned cvt_pk_bf16(float lo, float hi) { unsigned r; asm volatile("v_cvt_pk_bf16_f32 %0, %1, %2" : "=v"(r) : "v"(lo), "v"(hi)); return r; }
typedef float f32x2 __attribute__((ext_vector_type(2)));
typedef unsigned u32x4e __attribute__((ext_vector_type(4)));
constexpr float QK_C2 = 0.125f * 1.4426950408889634f;
constexpr float RMS_EPS = 1e-6f;
struct EpiProj {
    static constexpr bool PERM = true, AFTER_DRAIN = false;
    bf16_t* O; int ldc; const float* rstd;
    __device__ __forceinline__ void operator()(const f32x4 (&acc)[2][2][4][2], const Unit& u, int wr, int wc, int fr, int fq) const {
        const int row0 = u.pm * BM + wr * 64 + fr, col0 = u.pn * BM + wc * 32 + 8 * fq;
        const float cs = (u.pn < 2 || u.pn == 6 || u.pn == 7) ? QK_C2 : 1.f;
#pragma unroll
        for (int ai = 0; ai < 2; ++ai)
#pragma unroll
            for (int m = 0; m < 4; ++m) { const int row = row0 + ai * HALF + m * 16; const float rs = rstd[row] * cs; bf16_t* rowp = O + (size_t)row * ldc + col0;
#pragma unroll
                for (int bj = 0; bj < 2; ++bj) { const f32x4 v0 = acc[ai][bj][m][0] * rs, v1 = acc[ai][bj][m][1] * rs;
                    u32x4e w; w.x = cvt_pk_bf16(v0[0], v0[1]); w.y = cvt_pk_bf16(v0[2], v0[3]); w.z = cvt_pk_bf16(v1[0], v1[1]); w.w = cvt_pk_bf16(v1[2], v1[3]);
                    *(u32x4e*)(rowp + bj * HALF) = w; } }
    }
};
struct EpiRes {
    static constexpr bool PERM = true, AFTER_DRAIN = false;
    const float* X; float* H; bf16_t* HB; float* ssq;
    __device__ __forceinline__ void operator()(const f32x4 (&acc)[2][2][4][2], const Unit& u, int wr, int wc, int fr, int fq) const {
        const int row0 = u.pm * BM + wr * 64 + fr, col0 = u.pn * BM + wc * 32 + 8 * fq;
#pragma unroll
        for (int ai = 0; ai < 2; ++ai)
#pragma unroll
            for (int m = 0; m < 4; ++m) { const int row = row0 + ai * HALF + m * 16; const size_t off = (size_t)row * 1024 + col0; float s = 0.f;
#pragma unroll
                for (int bj = 0; bj < 2; ++bj) {
                    const f32x4 h0 = *(const f32x4*)(X + off + bj * HALF) + acc[ai][bj][m][0], h1 = *(const f32x4*)(X + off + bj * HALF + 4) + acc[ai][bj][m][1];
                    *(f32x4*)(H + off + bj * HALF) = h0; *(f32x4*)(H + off + bj * HALF + 4) = h1;
                    s += (h0[0] * h0[0] + h0[1] * h0[1]) + (h0[2] * h0[2] + h0[3] * h0[3]) + (h1[0] * h1[0] + h1[1] * h1[1]) + (h1[2] * h1[2] + h1[3] * h1[3]);
                    if (HB) { u32x4e w; w.x = cvt_pk_bf16(h0[0], h0[1]); w.y = cvt_pk_bf16(h0[2], h0[3]); w.z = cvt_pk_bf16(h1[0], h1[1]); w.w = cvt_pk_bf16(h1[2], h1[3]);
                        *(u32x4e*)(HB + off + bj * HALF) = w; } }
                s += __shfl_xor(s, 16); s += __shfl_xor(s, 32);
                if (fq == 0) ssq[(size_t)row * 16 + u.pn * 4 + wc] = s; }
    }
};
struct EpiUp {
    static constexpr bool PERM = true, AFTER_DRAIN = false;
    bf16_t* O; int ldc; const float* ssq;
    __device__ __forceinline__ void operator()(const f32x4 (&acc)[2][2][4][2], const Unit& u, int wr, int wc, int fr, int fq) const {
        const int row0 = u.pm * BM + wr * 64 + fr, col0 = u.pn * BM + wc * 32 + 8 * fq;
#pragma unroll
        for (int ai = 0; ai < 2; ++ai)
#pragma unroll
            for (int m = 0; m < 4; ++m) { const int row = row0 + ai * HALF + m * 16; const f32x4* sp = (const f32x4*)(ssq + (size_t)row * 16);
                const f32x4 a = sp[0], b = sp[1], c = sp[2], d = sp[3];
                const float tot = ((a[0] + a[1]) + (a[2] + a[3])) + ((b[0] + b[1]) + (b[2] + b[3])) + ((c[0] + c[1]) + (c[2] + c[3])) + ((d[0] + d[1]) + (d[2] + d[3]));
                const float rs = __builtin_amdgcn_rsqf(tot * (1.0f / 1024.0f) + RMS_EPS); bf16_t* rowp = O + (size_t)row * ldc + col0;
#pragma unroll
                for (int bj = 0; bj < 2; ++bj) { f32x4 v0 = acc[ai][bj][m][0] * rs, v1 = acc[ai][bj][m][1] * rs;
#pragma unroll
                    for (int e = 0; e < 4; ++e) { const float p = fmaxf(v0[e], 0.f), q = fmaxf(v1[e], 0.f); v0[e] = p * p; v1[e] = q * q; }
                    u32x4e w; w.x = cvt_pk_bf16(v0[0], v0[1]); w.y = cvt_pk_bf16(v0[2], v0[3]); w.z = cvt_pk_bf16(v1[0], v1[1]); w.w = cvt_pk_bf16(v1[2], v1[3]);
                    *(u32x4e*)(rowp + bj * HALF) = w; } }
    }
};
template <class Epi, class Sched, bool ALIGN_EPI = false, bool SP2 = false>
__device__ __forceinline__ void gemm_phase(PG8_LAS unsigned char* lds, const Gemm g, const Sched& S, const Epi& E) {
    const int tid = threadIdx.x, wid = __builtin_amdgcn_readfirstlane(tid >> 6), lane = tid & 63, wr = wid >> 2, wc = wid & 3, fr = lane & 15, fq = lane >> 4;
    const int K = g.K, nt = K / BK;
    unsigned voffA[2], voffB[2];
#pragma unroll
    for (int i = 0; i < 2; ++i) { int R, C; stage_rc(tid * 16 + i * 8192, R, C); const int Rb = Epi::PERM ? ((R & ~31) + perm32(R & 31)) : R;
        voffA[i] = (unsigned)(R * K + C) * 2u; voffB[i] = (unsigned)(Rb * K + C) * 2u; }
    const size_t kstep = (size_t)(BK * 2);
    const size_t hstep = (size_t)HALF * K * 2;
    const size_t tstep = 2 * hstep;
    const unsigned ldsw = (unsigned)wid * 1024u;
    const int aoff = lds_byte(wr * 64 + fr, fq * 8), boff = lds_byte(wc * 32 + fr, fq * 8);
#define PG8_SA(b, h) (((b) * 2 + (h)) * HTB)
#define PG8_SB(b, h) ((4 + (b) * 2 + (h)) * HTB)
#define PG8_STAGE(bufoff, gbase, voff) do { _Pragma("unroll") for (int _i = 0; _i < 2; ++_i) \
        __builtin_amdgcn_global_load_lds((const unsigned*)((const char*)(gbase) + (voff)[_i]), (PG8_LAS unsigned*)(lds + (bufoff) + ldsw + _i * 8192), 16, 0, 0); } while (0)
#define PG8_LDA(dst, b, h) do { _Pragma("unroll") for (int m = 0; m < 4; ++m) _Pragma("unroll") for (int k = 0; k < 2; ++k) dst[m][k] = *(const PG8_LAS bf16x8*)(lds + PG8_SA(b, h) + aoff + m * 2048 + k * 1024); } while (0)
#define PG8_LDB(dst, b, h) do { _Pragma("unroll") for (int n = 0; n < 2; ++n) _Pragma("unroll") for (int k = 0; k < 2; ++k) dst[n][k] = *(const PG8_LAS bf16x8*)(lds + PG8_SB(b, h) + boff + n * 2048 + k * 1024); } while (0)
#define PG8_MMA(ai, bj, At, Bt) do { __builtin_amdgcn_s_setprio(1); _Pragma("unroll") for (int m = 0; m < 4; ++m) _Pragma("unroll") for (int n = 0; n < 2; ++n) _Pragma("unroll") for (int k = 0; k < 2; ++k) \
        acc[ai][bj][m][n] = __builtin_amdgcn_mfma_f32_16x16x32_bf16(Bt[n][k], At[m][k], acc[ai][bj][m][n], 0, 0, 0); __builtin_amdgcn_s_setprio(0); } while (0)
#define PG8_WAIT_V(n) asm volatile("s_waitcnt vmcnt(" #n ")" ::: "memory")
#define PG8_WAIT_L(n) asm volatile("s_waitcnt lgkmcnt(" #n ")" ::: "memory")
#define PG8_BAR __builtin_amdgcn_s_barrier()
#define PG8_SCHED __builtin_amdgcn_sched_barrier(0)
    Unit cur, nxt; int ui = 0;
    if (!S.next(0, cur)) return;
    f32x4 acc[2][2][4][2];
#pragma unroll
    for (int a = 0; a < 2; ++a)
#pragma unroll
        for (int b = 0; b < 2; ++b)
#pragma unroll
            for (int m = 0; m < 4; ++m)
#pragma unroll
                for (int n = 0; n < 2; ++n) acc[a][b][m][n] = (f32x4){0.f, 0.f, 0.f, 0.f};
    bf16x8 At[4][2], B0[2][2], B1[2][2];
    const char* cA = (const char*)g.A + (size_t)cur.pm * tstep; const char* cB = (const char*)g.Bt + (size_t)cur.pn * tstep;
    S.a_ready(cur);
    if constexpr (SP2) {
        PG8_STAGE(PG8_SB(0, 0), cB, voffB); PG8_STAGE(PG8_SB(0, 1), cB + hstep, voffB); PG8_STAGE(PG8_SA(0, 0), cA, voffA); PG8_STAGE(PG8_SA(0, 1), cA + hstep, voffA);
        if (wr == 1) PG8_BAR;
        PG8_WAIT_V(2); PG8_BAR;
        PG8_STAGE(PG8_SB(1, 0), cB + kstep, voffB); PG8_STAGE(PG8_SA(1, 0), cA + kstep, voffA); PG8_STAGE(PG8_SB(1, 1), cB + hstep + kstep, voffB);
        PG8_WAIT_V(6); PG8_BAR;
    } else {
        PG8_STAGE(PG8_SB(0, 0), cB, voffB); PG8_STAGE(PG8_SA(0, 0), cA, voffA); PG8_STAGE(PG8_SB(0, 1), cB + hstep, voffB); PG8_STAGE(PG8_SA(0, 1), cA + hstep, voffA);
        if (wr == 1) PG8_BAR;
        PG8_WAIT_V(4); PG8_BAR;
        PG8_STAGE(PG8_SB(1, 0), cB + kstep, voffB); PG8_STAGE(PG8_SA(1, 0), cA + kstep, voffA); PG8_STAGE(PG8_SB(1, 1), cB + hstep + kstep, voffB);
        PG8_WAIT_V(6); PG8_BAR;
    }
    for (;;) {
        const bool has_next = S.next(ui + 1, nxt);
        const char* nA = has_next ? (const char*)g.A + (size_t)nxt.pm * tstep : cA; const char* nB = has_next ? (const char*)g.Bt + (size_t)nxt.pn * tstep : cB;
        for (int t = 0; t < nt; t += 2) {
            const bool last = (t == nt - 2);
            const char* a1 = cA + (size_t)(t + 1) * kstep;
            const char* a2 = last ? nA : cA + (size_t)(t + 2) * kstep; const char* b2 = last ? nB : cB + (size_t)(t + 2) * kstep;
            const char* a3 = a2 + kstep; const char* b3 = b2 + kstep;
            if (last && has_next) S.a_ready(nxt);
            if constexpr (SP2) {
            PG8_LDB(B0, 0, 0); PG8_LDB(B1, 0, 1); PG8_SCHED; PG8_LDA(At, 0, 0); PG8_STAGE(PG8_SA(1, 1), a1 + hstep, voffA);
            PG8_WAIT_V(8); PG8_WAIT_L(0); PG8_BAR; PG8_MMA(0, 0, At, B0); PG8_MMA(0, 1, At, B1); PG8_BAR; PG8_SCHED;
            PG8_LDA(At, 0, 1); PG8_STAGE(PG8_SB(0, 0), b2, voffB); PG8_STAGE(PG8_SB(0, 1), b2 + hstep, voffB); PG8_STAGE(PG8_SA(0, 0), a2, voffA);
            PG8_WAIT_V(8); PG8_WAIT_L(0); PG8_BAR; PG8_MMA(1, 0, At, B0); PG8_MMA(1, 1, At, B1); PG8_BAR; PG8_SCHED;
            PG8_LDB(B0, 1, 0); PG8_LDB(B1, 1, 1); PG8_SCHED; PG8_LDA(At, 1, 0); PG8_STAGE(PG8_SA(0, 1), a2 + hstep, voffA);
            PG8_WAIT_V(8); PG8_WAIT_L(0); PG8_BAR; PG8_MMA(0, 0, At, B0); PG8_MMA(0, 1, At, B1); PG8_BAR; PG8_SCHED;
            PG8_LDA(At, 1, 1); PG8_STAGE(PG8_SB(1, 0), b3, voffB); PG8_STAGE(PG8_SB(1, 1), b3 + hstep, voffB); PG8_STAGE(PG8_SA(1, 0), a3, voffA);
            PG8_WAIT_V(8); PG8_WAIT_L(0); PG8_BAR; PG8_MMA(1, 0, At, B0); PG8_MMA(1, 1, At, B1); PG8_BAR; PG8_SCHED;
            } else {
            PG8_LDB(B0, 0, 0); PG8_SCHED; PG8_LDA(At, 0, 0); PG8_STAGE(PG8_SA(1, 1), a1 + hstep, voffA);
            PG8_WAIT_L(8); PG8_BAR; PG8_WAIT_L(0); PG8_MMA(0, 0, At, B0); PG8_BAR; PG8_SCHED;
            PG8_LDB(B1, 0, 1); PG8_STAGE(PG8_SB(0, 0), b2, voffB);
            PG8_BAR; PG8_WAIT_L(0); PG8_MMA(0, 1, At, B1); PG8_BAR;
            PG8_LDA(At, 0, 1); PG8_STAGE(PG8_SA(0, 0), a2, voffA);
            PG8_BAR; PG8_WAIT_L(0); PG8_MMA(1, 0, At, B0); PG8_BAR; PG8_SCHED;
            PG8_STAGE(PG8_SB(0, 1), b2 + hstep, voffB);
            PG8_WAIT_V(6); PG8_BAR; PG8_MMA(1, 1, At, B1); PG8_BAR;
            PG8_LDB(B0, 1, 0); PG8_SCHED; PG8_LDA(At, 1, 0); PG8_STAGE(PG8_SA(0, 1), a2 + hstep, voffA);
            PG8_WAIT_L(8); PG8_BAR; PG8_WAIT_L(0); PG8_MMA(0, 0, At, B0); PG8_BAR; PG8_SCHED;
            PG8_LDB(B1, 1, 1); PG8_STAGE(PG8_SB(1, 0), b3, voffB);
            PG8_BAR; PG8_WAIT_L(0); PG8_MMA(0, 1, At, B1); PG8_BAR;
            PG8_LDA(At, 1, 1); PG8_STAGE(PG8_SA(1, 0), a3, voffA);
            PG8_BAR; PG8_WAIT_L(0); PG8_MMA(1, 0, At, B0); PG8_BAR; PG8_SCHED;
            PG8_STAGE(PG8_SB(1, 1), b3 + hstep, voffB);
            PG8_WAIT_V(6); PG8_BAR; PG8_MMA(1, 1, At, B1); PG8_BAR;
            }
        }
        if constexpr (ALIGN_EPI) { if (wr == 0) PG8_BAR; }
        if constexpr (!Epi::AFTER_DRAIN) { E(acc, cur, wr, wc, fr, fq); S.done(cur); }
        if (!has_next) break;
#pragma unroll
        for (int a = 0; a < 2; ++a)
#pragma unroll
            for (int b = 0; b < 2; ++b)
#pragma unroll
                for (int m = 0; m < 4; ++m)
#pragma unroll
                    for (int n = 0; n < 2; ++n) acc[a][b][m][n] = (f32x4){0.f, 0.f, 0.f, 0.f};
        cur = nxt; cA = nA; cB = nB; ++ui;
        if constexpr (ALIGN_EPI) { if (wr == 1) PG8_BAR; }
    }
    PG8_WAIT_V(0);
    if constexpr (!ALIGN_EPI) { if (wr == 0) PG8_BAR; }
    PG8_BAR;
    if constexpr (Epi::AFTER_DRAIN) { E.fused(acc, cur, wr, wc, fr, fq, lds, wid, lane); S.done(cur); }
#undef PG8_SA
#undef PG8_SB
#undef PG8_STAGE
#undef PG8_LDA
#undef PG8_LDB
#undef PG8_MMA
#undef PG8_WAIT_V
#undef PG8_WAIT_L
#undef PG8_BAR
#undef PG8_SCHED
}
}
namespace att {
#define ATT_LAS __attribute__((address_space(3)))
typedef unsigned short bf16_t;
typedef short bf16x8 __attribute__((ext_vector_type(8)));
typedef _Float16 f16x8 __attribute__((ext_vector_type(8)));
typedef _Float16 f16x2 __attribute__((ext_vector_type(2)));
typedef float f32x16 __attribute__((ext_vector_type(16)));
typedef float f32x4 __attribute__((ext_vector_type(4)));
typedef float f32x2 __attribute__((ext_vector_type(2)));
typedef __bf16 bf16x2_t __attribute__((ext_vector_type(2)));
typedef short s16x4 __attribute__((ext_vector_type(4)));
typedef short v4i16_t __attribute__((ext_vector_type(4)));
typedef unsigned u32x4 __attribute__((ext_vector_type(4)));
typedef unsigned u32x2 __attribute__((ext_vector_type(2)));
typedef ATT_LAS unsigned char* ldsp;
typedef ATT_LAS const unsigned char* cldsp;

constexpr int SEQ = 2048, PITCH = 3072, MIXP = 1024, SLOTB = 32768;
constexpr float LOG2E = 1.4426950408889634f;
constexpr float THR = 8.0f;
constexpr float SB_DONE = 150.0f;

__device__ __forceinline__ int crow(int r, int hi) { return (r & 3) + 8 * (r >> 2) + 4 * hi; }
__device__ __forceinline__ unsigned pk_bf16(float lo, float hi) { f32x2 v = {lo, hi}; return __builtin_bit_cast(unsigned, __builtin_convertvector(v, bf16x2_t)); }
__device__ __forceinline__ unsigned pk_f16(float lo, float hi) { f32x2 v = {lo, hi}; return __builtin_bit_cast(unsigned, __builtin_convertvector(v, f16x2)); }
__device__ __forceinline__ void dma16(const void* g, ldsp l) { __builtin_amdgcn_global_load_lds((const unsigned*)g, (ATT_LAS unsigned*)l, 16, 0, 0); }
__device__ __forceinline__ s16x4 vtr(cldsp p) { return __builtin_bit_cast(s16x4, __builtin_amdgcn_ds_read_tr16_b64_v4i16((ATT_LAS v4i16_t*)p)); }
__device__ __forceinline__ float pmax32(float v) { auto rr = __builtin_amdgcn_permlane32_swap(__float_as_uint(v), __float_as_uint(v), false, false); return fmaxf(__uint_as_float(rr[0]), __uint_as_float(rr[1])); }
__device__ __forceinline__ float psum32(float v) { auto rr = __builtin_amdgcn_permlane32_swap(__float_as_uint(v), __float_as_uint(v), false, false); return __uint_as_float(rr[0]) + __uint_as_float(rr[1]); }
__device__ __forceinline__ bf16x8 packbf(const f32x16& p, int b) { u32x4 w; w.x = pk_bf16(p[b], p[b + 1]); w.y = pk_bf16(p[b + 2], p[b + 3]); w.z = pk_bf16(p[b + 4], p[b + 5]); w.w = pk_bf16(p[b + 6], p[b + 7]); return __builtin_bit_cast(bf16x8, w); }
__device__ __forceinline__ f16x8 packh(const f32x16& p, int b) { u32x4 w; w.x = pk_f16(p[b], p[b + 1]); w.y = pk_f16(p[b + 2], p[b + 3]); w.z = pk_f16(p[b + 4], p[b + 5]); w.w = pk_f16(p[b + 6], p[b + 7]); return __builtin_bit_cast(f16x8, w); }

__device__ __forceinline__ void qkt(f32x16& s0, f32x16& s1, cldsp Ks, const bf16x8* qf, const f32x16& c0, const f32x16& c1, int r32, int hi) {
    cldsp kb = Ks + hi * 1024 + r32 * 16;
    s0 = c0; s1 = c1;
#pragma unroll
    for (int d0 = 0; d0 < 4; ++d0) {
        const bf16x8 b0 = *(ATT_LAS const bf16x8*)(kb + d0 * 2048);
        const bf16x8 b1 = *(ATT_LAS const bf16x8*)(kb + d0 * 2048 + 512);
        s0 = __builtin_amdgcn_mfma_f32_32x32x16_bf16(b0, qf[d0], s0, 0, 0, 0);
        s1 = __builtin_amdgcn_mfma_f32_32x32x16_bf16(b1, qf[d0], s1, 0, 0, 0);
    }
}
template <int NE> __device__ __forceinline__ void pv(f32x16* o, cldsp Vs, int vb, const bf16x8* pf) {
#pragma unroll
    for (int eb = 0; eb < NE; ++eb)
#pragma unroll
        for (int ks = 0; ks < 4; ++ks) {
            const s16x4 lo = vtr(Vs + vb + eb * 4096 + ks * 1024), hh = vtr(Vs + vb + eb * 4096 + ks * 1024 + 512);
            const bf16x8 a = {lo[0], lo[1], lo[2], lo[3], hh[0], hh[1], hh[2], hh[3]};
            o[eb] = __builtin_amdgcn_mfma_f32_32x32x16_bf16(a, pf[ks], o[eb], 0, 0, 0);
        }
}
#define ATT_WAIT_BAR() do { asm volatile("s_waitcnt vmcnt(0) lgkmcnt(0)" ::: "memory"); __syncthreads(); } while (0)

__device__ __forceinline__ void diff_unit(int b, int h, int qb, const bf16_t* proj, bf16_t* mixed, ldsp lds, float lam, const float* subln_g) {
    const int tid = threadIdx.x, lane = tid & 63, r32 = lane & 31, hi = lane >> 5;
    const int wid = __builtin_amdgcn_readfirstlane(tid >> 6), pr = wid & 3, mp = wid >> 2;
    const int q0 = qb * 128, c0 = q0 >> 6, cw = c0 + (pr >> 1), R0 = q0 + 32 * pr;
    const size_t rowbase = (size_t)b * SEQ;
    const float slope2 = exp2f(-2.0f * (float)(h + 1)) * LOG2E;
    const bf16_t* Qw = proj + (rowbase + R0 + r32) * PITCH + h * 128 + mp * 64 + hi * 8;
    bf16x8 qf[4];
#pragma unroll
    for (int d0 = 0; d0 < 4; ++d0) qf[d0] = *(const bf16x8*)(Qw + d0 * 16);
    const bf16_t* ksrc = proj + (rowbase + lane) * PITCH + 512 + h * 128 + wid * 8;
    const bf16_t* vsrc = proj + (rowbase + (2 * (wid & 1)) * 16 + (lane >> 2)) * PITCH + 1024 + h * 128 + (wid >> 1) * 32 + (lane & 3) * 8;
    const int vdst = 16384 + (wid >> 1) * 4096 + (2 * (wid & 1)) * 1024;
    const int vb = (4 * hi + ((lane & 15) >> 2)) * 64 + ((lane >> 4) & 1) * 32 + (lane & 3) * 8;
#define DF_ISSUE(j, slot) do { ldsp sb_ = lds + (slot) * SLOTB; const size_t to_ = (size_t)(j) * 64 * PITCH; \
        dma16(ksrc + to_, sb_ + wid * 1024); dma16(ksrc + to_ + 64, sb_ + 8192 + wid * 1024); \
        dma16(vsrc + to_, sb_ + vdst); dma16(vsrc + to_ + 16 * PITCH, sb_ + vdst + 1024); } while (0)
    f32x16 o[4];
#pragma unroll
    for (int e = 0; e < 4; ++e) o[e] = f32x16{};
    float mref = 0.f, l = 0.f;
    const float tq = (float)(R0 + r32);
    DF_ISSUE(c0 + 1, 0);
    int it = 0;
    for (int j = c0 + 1; j >= 0; --j, ++it) {
        ATT_WAIT_BAR();
        if (j > 0) DF_ISSUE(j - 1, (it + 1) & 1);
        if (j <= cw) {
            cldsp sb = lds + (it & 1) * SLOTB;
            f32x16 cv0, cv1;
            if (j == cw) { const float trel = tq - (float)(64 * cw);
#pragma unroll
                for (int r = 0; r < 16; ++r) { const float kk = (float)crow(r, hi); cv0[r] = -slope2 * fabsf(kk - trel) - mref; cv1[r] = -slope2 * fabsf(kk + 32.f - trel) - mref; }
            } else { const float base = slope2 * ((float)(64 * j + 4 * hi) - tq) - mref;
#pragma unroll
                for (int r = 0; r < 16; ++r) { const float cr = (float)((r & 3) + 8 * (r >> 2)); cv0[r] = fmaf(slope2, cr, base); cv1[r] = fmaf(slope2, cr + 32.f, base); }
            }
            f32x16 s0, s1; qkt(s0, s1, sb + mp * 8192, qf, cv0, cv1, r32, hi);
            float rm = fmaxf(s0[0], s1[0]);
#pragma unroll
            for (int r = 1; r < 16; ++r) rm = fmaxf(rm, fmaxf(s0[r], s1[r]));
            rm = pmax32(rm);
            const bool first = (j == cw);
            if (first || __any(rm > THR)) {
                const float dl = first ? rm : fmaxf(rm, 0.f); mref += dl;
#pragma unroll
                for (int r = 0; r < 16; ++r) { s0[r] -= dl; s1[r] -= dl; }
                if (!first) { const float f = __builtin_amdgcn_exp2f(-dl); l *= f;
#pragma unroll
                    for (int e = 0; e < 4; ++e)
#pragma unroll
                        for (int r = 0; r < 16; ++r) o[e][r] *= f; }
            }
            float sa = 0.f, sb2 = 0.f;
#pragma unroll
            for (int r = 0; r < 16; ++r) { s0[r] = __builtin_amdgcn_exp2f(s0[r]); s1[r] = __builtin_amdgcn_exp2f(s1[r]); sa += s0[r]; sb2 += s1[r]; }
            l += sa + sb2;
            bf16x8 pf[4]; pf[0] = packbf(s0, 0); pf[1] = packbf(s0, 8); pf[2] = packbf(s1, 0); pf[3] = packbf(s1, 8);
            pv<4>(o, sb + 16384, vb, pf);
        }
    }
    ATT_WAIT_BAR();
    l = psum32(l); const float inv = 1.0f / l;
    ATT_LAS float* xch = (ATT_LAS float*)lds + pr * 4096;
    if (mp == 1) {
#pragma unroll
        for (int e = 0; e < 4; ++e)
#pragma unroll
            for (int r = 0; r < 16; ++r) xch[(e * 16 + r) * 64 + lane] = o[e][r] * inv;
    }
    ATT_WAIT_BAR();
    if (mp == 0) {
        float ss = 0.f;
#pragma unroll
        for (int e = 0; e < 4; ++e)
#pragma unroll
            for (int r = 0; r < 16; ++r) { const float v = o[e][r] * inv - lam * xch[(e * 16 + r) * 64 + lane]; o[e][r] = v; ss += v * v; }
        ss = psum32(ss);
        const float rs = __builtin_amdgcn_rsqf(ss * (1.0f / 128.0f) + 1e-6f) * 0.8f;
        bf16_t* orow = mixed + (rowbase + R0 + r32) * MIXP + h * 128 + 4 * hi;
#pragma unroll
        for (int e = 0; e < 4; ++e)
#pragma unroll
            for (int g = 0; g < 4; ++g) { const f32x4 gg = *(const f32x4*)(subln_g + e * 32 + 8 * g + 4 * hi);
                u32x2 w; w.x = pk_bf16(o[e][4 * g] * rs * gg[0], o[e][4 * g + 1] * rs * gg[1]); w.y = pk_bf16(o[e][4 * g + 2] * rs * gg[2], o[e][4 * g + 3] * rs * gg[3]);
                *(u32x2*)(orow + e * 32 + 8 * g) = w; }
    }
    ATT_WAIT_BAR();
#undef DF_ISSUE
}

__device__ __forceinline__ void sb_unit(int b, int hp, int qb, const bf16_t* proj, bf16_t* mixed, ldsp lds, const float* sb_g, ATT_LAS unsigned* flags) {
    const int tid = threadIdx.x, lane = tid & 63, r32 = lane & 31, hi = lane >> 5;
    const int wid = __builtin_amdgcn_readfirstlane(tid >> 6), pr = wid & 3, hs = wid >> 2, head = 2 * hp + hs;
    const int q0 = qb * 128, c0 = q0 >> 6, cw = c0 + (pr >> 1), R0 = q0 + 32 * pr;
    const size_t rowbase = (size_t)b * SEQ;
    const bf16_t* Qw = proj + (rowbase + R0 + r32) * PITCH + 1536 + head * 64 + hi * 8;
    bf16x8 qf[4];
#pragma unroll
    for (int d0 = 0; d0 < 4; ++d0) qf[d0] = *(const bf16x8*)(Qw + d0 * 16);
    const bf16_t* ksrc = proj + (rowbase + lane) * PITCH + 2048 + (2 * hp) * 64 + wid * 8;
    const bf16_t* vsrc = proj + (rowbase + (wid & 3) * 16 + (lane >> 2)) * PITCH + 2560 + (2 * hp) * 64 + (wid >> 2) * 32 + (lane & 3) * 8;
    const int vdst = 16384 + (wid >> 2) * 4096 + (wid & 3) * 1024;
    const int vb = (4 * hi + ((lane & 15) >> 2)) * 64 + ((lane >> 4) & 1) * 32 + (lane & 3) * 8;
#define SB_ISSUE(j, slot) do { ldsp sb_ = lds + (slot) * SLOTB; const size_t to_ = (size_t)(j) * 64 * PITCH; \
        dma16(ksrc + to_, sb_ + wid * 1024); dma16(ksrc + to_ + 64, sb_ + 8192 + wid * 1024); \
        dma16(vsrc + to_, sb_ + vdst); dma16(vsrc + to_ + 64, sb_ + vdst + 8192); } while (0)
    f16x8 tri[2], ones;
#pragma unroll
    for (int s = 0; s < 2; ++s)
#pragma unroll
        for (int jj = 0; jj < 8; ++jj) { const int key = 16 * s + 8 * (jj >> 2) + 4 * hi + (jj & 3); tri[s][jj] = (key >= r32) ? (_Float16)1.0f : (_Float16)0.0f; }
#pragma unroll
    for (int jj = 0; jj < 8; ++jj) ones[jj] = (_Float16)1.0f;
    f32x16 o[2]; o[0] = f32x16{}; o[1] = f32x16{};
    f32x16 carry = f32x16{};
    bool wdone = false;
    SB_ISSUE(c0 + 1, 0);
    int it = 0;
    for (int j = c0 + 1; j >= 0; --j, ++it) {
        if (lane == 0) flags[(it & 1) * 8 + wid] = wdone ? 1u : 0u;
        ATT_WAIT_BAR();
        { const u32x4 fa = *(ATT_LAS const u32x4*)(flags + (it & 1) * 8), fb = *(ATT_LAS const u32x4*)(flags + (it & 1) * 8 + 4);
          if ((fa.x & fa.y & fa.z & fa.w & fb.x & fb.y & fb.z & fb.w) != 0u) break; }
        if (j > 0) SB_ISSUE(j - 1, (it + 1) & 1);
        if (j <= cw && !wdone) {
            cldsp sb = lds + (it & 1) * SLOTB;
            f32x16 z0, z1; { const f32x16 zz = f32x16{}; qkt(z0, z1, sb + hs * 8192, qf, zz, zz, r32, hi); }
            if (j == cw) { const int trel = R0 + r32 - 64 * j;
#pragma unroll
                for (int r = 0; r < 16; ++r) { const int kk = crow(r, hi); if (kk >= trel) z0[r] = -1e30f; if (kk + 32 >= trel) z1[r] = -1e30f; }
            }
            f32x16 p0, p1;
#pragma unroll
            for (int r = 0; r < 16; ++r) { z0[r] = fminf(z0[r], 60.f); z1[r] = fminf(z1[r], 60.f);
                p0[r] = __builtin_amdgcn_logf(1.0f + __builtin_amdgcn_exp2f(z0[r])); p1[r] = __builtin_amdgcn_logf(1.0f + __builtin_amdgcn_exp2f(z1[r])); }
            f16x8 sf[4]; sf[0] = packh(p0, 0); sf[1] = packh(p0, 8); sf[2] = packh(p1, 0); sf[3] = packh(p1, 8);
            f32x16 t1 = __builtin_amdgcn_mfma_f32_32x32x16_f16(ones, sf[2], carry, 0, 0, 0); t1 = __builtin_amdgcn_mfma_f32_32x32x16_f16(ones, sf[3], t1, 0, 0, 0);
            f32x16 i1 = __builtin_amdgcn_mfma_f32_32x32x16_f16(tri[0], sf[2], carry, 0, 0, 0); i1 = __builtin_amdgcn_mfma_f32_32x32x16_f16(tri[1], sf[3], i1, 0, 0, 0);
            f32x16 i0 = __builtin_amdgcn_mfma_f32_32x32x16_f16(tri[0], sf[0], t1, 0, 0, 0); i0 = __builtin_amdgcn_mfma_f32_32x32x16_f16(tri[1], sf[1], i0, 0, 0, 0);
            carry = __builtin_amdgcn_mfma_f32_32x32x16_f16(ones, sf[0], t1, 0, 0, 0); carry = __builtin_amdgcn_mfma_f32_32x32x16_f16(ones, sf[1], carry, 0, 0, 0);
#pragma unroll
            for (int r = 0; r < 16; ++r) { z0[r] = __builtin_amdgcn_exp2f(z0[r] - i0[r]); z1[r] = __builtin_amdgcn_exp2f(z1[r] - i1[r]); }
            bf16x8 pf[4]; pf[0] = packbf(z0, 0); pf[1] = packbf(z0, 8); pf[2] = packbf(z1, 0); pf[3] = packbf(z1, 8);
            pv<2>(o, sb + 16384 + hs * 8192, vb, pf);
            wdone = !__any(carry[0] < SB_DONE);
        }
    }
    {
        float ss = 0.f;
#pragma unroll
        for (int e = 0; e < 2; ++e)
#pragma unroll
            for (int r = 0; r < 16; ++r) ss += o[e][r] * o[e][r];
        ss = psum32(ss);
        const float rs = __builtin_amdgcn_rsqf(ss * (1.0f / 64.0f) + 1e-6f);
        bf16_t* orow = mixed + (rowbase + R0 + r32) * MIXP + 512 + head * 64 + 4 * hi;
#pragma unroll
        for (int e = 0; e < 2; ++e)
#pragma unroll
            for (int g = 0; g < 4; ++g) { const f32x4 gg = *(const f32x4*)(sb_g + e * 32 + 8 * g + 4 * hi);
                u32x2 w; w.x = pk_bf16(o[e][4 * g] * rs * gg[0], o[e][4 * g + 1] * rs * gg[1]); w.y = pk_bf16(o[e][4 * g + 2] * rs * gg[2], o[e][4 * g + 3] * rs * gg[3]);
                *(u32x2*)(orow + e * 32 + 8 * g) = w; }
    }
    ATT_WAIT_BAR();
#undef SB_ISSUE
}
}
#ifndef MK_N_LAUNCHES
#define MK_N_LAUNCHES 1
#endif
constexpr int N_PHASES = 7;
constexpr int M_ = 16384, D_ = 1024, NIN = 3072, FF_ = 4096, SEQ_ = 2048;
constexpr size_t MiB = 1u << 20;
constexpr size_t WS_WIN = 2 * MiB, WS_WOUT = 8 * MiB, WS_WUP = 10 * MiB, WS_WDN = 18 * MiB;
constexpr size_t WS_RSTD1 = 26 * MiB, WS_SSQ2 = 27 * MiB, WS_SSQ3 = 28 * MiB;
constexpr size_t WS_XB = 32 * MiB;
constexpr size_t WS_PROJ = 64 * MiB;
constexpr size_t WS_MIX = 160 * MiB;
constexpr size_t WS_U = 64 * MiB;
constexpr size_t WS_END = 192 * MiB;
constexpr int LDS_BYTES = 147456, FLAGS_OFF = 131072 + 512, BARW_OFF = 131072 + 1024;
constexpr size_t CTL_ZERO_BYTES = 65536; constexpr int CW_BAR = 4096;
#define LAS __attribute__((address_space(3)))
#define GAS __attribute__((address_space(1)))
typedef unsigned short bf16;
typedef unsigned v4u __attribute__((ext_vector_type(4)));
typedef float f32x4 __attribute__((ext_vector_type(4)));
#define LDS_WAIT() asm volatile("s_waitcnt lgkmcnt(0)" ::: "memory")
#define RLX_AGENT __ATOMIC_RELAXED, __HIP_MEMORY_SCOPE_AGENT
#define XB_TMO      128
#define XB_XCNT(j)  (256  + 64 * (j))
#define XB_XSUB(j)  (1280 + 64 * (j))
#define XB_XGEN(j)  (2304 + 64 * (j))
#define XB_TOP      3328
#define XB_TOPGEN   3392
#define XCD_BAR_WORDS 3456
#define XB_SPIN_CAP (1u << 18)

__device__ __forceinline__ unsigned xb_ld(unsigned* p)              { return __hip_atomic_load(p, __ATOMIC_RELAXED, __HIP_MEMORY_SCOPE_AGENT); }
__device__ __forceinline__ unsigned xb_add(unsigned* p, unsigned v) { return __hip_atomic_fetch_add(p, v, __ATOMIC_RELAXED, __HIP_MEMORY_SCOPE_AGENT); }
__device__ __forceinline__ unsigned xb_xcc_id() { return (unsigned)__builtin_amdgcn_s_getreg((3 << 11) | 20) & 0xFu; }
#define XB_SPIN(cond, bar) do { unsigned _sp = 0; while (cond) { __builtin_amdgcn_s_sleep(1); \
    if ((++_sp & 255u) == 0u) { if (xb_ld(&(bar)[XB_TMO])) break; if (_sp > XB_SPIN_CAP) { atomicAdd(&(bar)[XB_TMO], 1u); break; } } } } while (0)

struct XcdBarrier {
    unsigned* bar; unsigned x;
    volatile LAS unsigned* st;
};

__device__ __forceinline__ XcdBarrier xcd_barrier_post(unsigned* bar, volatile LAS unsigned* st) {
    XcdBarrier b; b.bar = bar; b.x = xb_xcc_id(); b.st = st;
    if (threadIdx.x == 0) (void)xb_add(&bar[XB_XCNT(b.x)], 1u);
    return b;
}
__device__ __forceinline__ void xcd_barrier_complete(unsigned* bar, unsigned x, unsigned& nloc, unsigned& nx) {
    const unsigned G = gridDim.x * gridDim.y * gridDim.z;
    unsigned sum, cnt, mine, sp = 0u;
    for (;;) {
        sum = 0u; cnt = 0u; mine = 0u;
#pragma unroll
        for (unsigned j = 0; j < 16; ++j) { const unsigned c = xb_ld(&bar[XB_XCNT(j)]); sum += c; cnt += (c > 0u) ? 1u : 0u; mine = (j == x) ? c : mine; }
        if (sum == G) break;
        __builtin_amdgcn_s_sleep(1);
        if ((++sp & 255u) == 0u) { if (xb_ld(&bar[XB_TMO])) break; if (sp > XB_SPIN_CAP) { atomicAdd(&bar[XB_TMO], 1u); break; } }
    }
    nloc = mine > 0u ? mine : 1u; nx = cnt > 0u ? cnt : 1u;
}

__device__ __forceinline__ void xcd_barrier(const XcdBarrier& b) {
    asm volatile("s_waitcnt vmcnt(0)" ::: "memory");
    __syncthreads();
    if (threadIdx.x == 0) {
        unsigned* bar = b.bar;
        __builtin_amdgcn_s_waitcnt(0);
        unsigned nloc = b.st[0], nx = b.st[1];
        if (nloc == 0u) { xcd_barrier_complete(bar, b.x, nloc, nx); b.st[0] = nloc; b.st[1] = nx; }
        const unsigned old = xb_add(&bar[XB_XSUB(b.x)], 1u);
        const unsigned gen = old / nloc;
        if (old + 1u == (gen + 1u) * nloc) {
            __builtin_amdgcn_fence(__ATOMIC_RELEASE, "agent");
            asm volatile("s_waitcnt vmcnt(0)" ::: "memory");
            const unsigned og = xb_add(&bar[XB_TOP], 1u);
            const unsigned tg = og / nx;
            if (og + 1u == (tg + 1u) * nx) xb_add(&bar[XB_TOPGEN], 1u);
            else XB_SPIN(xb_ld(&bar[XB_TOPGEN]) == tg, bar);
            __builtin_amdgcn_fence(__ATOMIC_ACQUIRE, "agent");
            xb_add(&bar[XB_XGEN(b.x)], 1u);
            asm volatile("s_waitcnt vmcnt(0)" ::: "memory");
        } else {
            XB_SPIN(xb_ld(&bar[XB_XGEN(b.x)]) == gen, bar);
            __builtin_amdgcn_fence(__ATOMIC_ACQUIRE, "agent");
            asm volatile("s_waitcnt vmcnt(0)" ::: "memory");
        }
    }
    __syncthreads();
}

__device__ __forceinline__ unsigned f2bf(float f) { unsigned u = __builtin_bit_cast(unsigned, f); return (u + 0x7fffu + ((u >> 16) & 1u)) >> 16; }
__device__ __forceinline__ unsigned pk2(float lo, float hi) { return f2bf(lo) | (f2bf(hi) << 16); }
__device__ __forceinline__ float wave_sum(float v) {
#pragma unroll
    for (int o = 1; o < 64; o <<= 1) v += __shfl_xor(v, o);
    return v;
}
__device__ __forceinline__ void p0_transpose_item(const float* W, const float* g, int K, int N, bf16* WT, LAS float* scr, int item, int lane) {
    const int nblk = N / 32, kb = item / nblk, nb = item % nblk, k0 = 64 * kb, n0 = 32 * nb;
#pragma unroll 8
    for (int i = 0; i < 32; ++i) { const int kk = 2 * i + (lane >> 5); const float gs = g ? g[k0 + kk] : 1.0f; scr[kk * 33 + (lane & 31)] = W[(size_t)(k0 + kk) * N + n0 + (lane & 31)] * gs; }
    LDS_WAIT(); asm volatile("" ::: "memory");
    const int c = lane & 7;
#pragma unroll
    for (int j = 0; j < 4; ++j) { const int n = (lane >> 3) + 8 * j; const LAS float* s = scr + (8 * c) * 33 + n;
        v4u o; o.x = pk2(s[0 * 33], s[1 * 33]); o.y = pk2(s[2 * 33], s[3 * 33]); o.z = pk2(s[4 * 33], s[5 * 33]); o.w = pk2(s[6 * 33], s[7 * 33]);
        *(GAS v4u*)(WT + (size_t)(n0 + n) * K + k0 + 8 * c) = o; }
    LDS_WAIT(); asm volatile("" ::: "memory");
}

struct Args { const float* in[14]; float* out; unsigned char* ws; int ph_lo, ph_hi, use_cg, pad; };
__global__ void __launch_bounds__(512, 2) fwd_kernel(Args args) {
    extern __shared__ __attribute__((aligned(16))) unsigned char lds_raw[];
    LAS unsigned char* lds = (LAS unsigned char*)lds_raw;
    const int tid = threadIdx.x, lane = tid & 63, wave = __builtin_amdgcn_readfirstlane(tid >> 6);
    const int G = gridDim.x, blk = blockIdx.x;
    unsigned char* ws = args.ws;
    const float* x = args.in[0]; const float* norm1_g = args.in[1]; const float* w_in = args.in[2];
    const float* lq1 = args.in[3]; const float* lk1 = args.in[4]; const float* lq2 = args.in[5]; const float* lk2 = args.in[6];
    const float* subln_g = args.in[7]; const float* sb_g = args.in[8]; const float* w_out = args.in[9]; const float* norm2_g = args.in[10];
    const float* w_up = args.in[11]; const float* w_down = args.in[12]; const float* fin_g = args.in[13];
    float* out = args.out;
    bf16* WinT = (bf16*)(ws + WS_WIN); bf16* WoutT = (bf16*)(ws + WS_WOUT); bf16* WupT = (bf16*)(ws + WS_WUP); bf16* WdnT = (bf16*)(ws + WS_WDN);
    float* rstd1 = (float*)(ws + WS_RSTD1); float* ssq2 = (float*)(ws + WS_SSQ2); float* ssq3 = (float*)(ws + WS_SSQ3);
    bf16* XB = (bf16*)(ws + WS_XB); bf16* PROJ = (bf16*)(ws + WS_PROJ); bf16* MIX = (bf16*)(ws + WS_MIX); bf16* UB = (bf16*)(ws + WS_U);
    const int lo = args.ph_lo, hi = args.ph_hi;
    volatile LAS unsigned* BARW = (volatile LAS unsigned*)(lds + BARW_OFF);
    if (tid < 2) BARW[tid] = 0u;
    __syncthreads();
    XcdBarrier bar = xcd_barrier_post((unsigned*)ws + CW_BAR, BARW);
#define IN(k) (lo <= (k) && (k) < hi)
#ifndef PROBE_PH
#define PROBE_PH -1
#endif
#ifndef PROBE_P5
#define PROBE_P5 0
#endif
#define PROBE_REP(k) ((k) == PROBE_PH ? 2 : 1)
#ifndef PROBE_SYNC
#define PROBE_SYNC 1
#endif
#define SEAM(k) do { if (IN(k) && IN((k) + 1)) { for (int rs_ = 0; rs_ < PROBE_SYNC; ++rs_) { if (args.use_cg) cg::this_grid().sync(); else xcd_barrier(bar); } } } while (0)

#if PROBE_PH == 0
    if (IN(0)) {
        LAS float* scr = (LAS float*)(lds + wave * 16384);
        const int gw = blk * 8 + wave, NGW = G * 8;
        constexpr int I_IN = (D_ / 64) * (NIN / 32), I_O = (D_ / 64) * (D_ / 32), I_UP = (D_ / 64) * (FF_ / 32), I_DN = (FF_ / 64) * (D_ / 32);
        for (int it = gw; it < I_IN + I_O + I_UP + I_DN; it += NGW) {
            int r = it;
            if (r < I_IN) { p0_transpose_item(w_in, norm1_g, D_, NIN, WinT, scr, r, lane); continue; } r -= I_IN;
            if (r < I_O) { p0_transpose_item(w_out, nullptr, D_, D_, WoutT, scr, r, lane); continue; } r -= I_O;
            if (r < I_UP) { p0_transpose_item(w_up, norm2_g, D_, FF_, WupT, scr, r, lane); continue; } r -= I_UP;
            p0_transpose_item(w_down, nullptr, FF_, D_, WdnT, scr, r, lane);
        }
        for (int m = gw; m < M_; m += NGW) {
            const GAS f32x4* xr = (const GAS f32x4*)(x + (size_t)m * D_) + lane;
            f32x4 v[4]; float s = 0.f;
#pragma unroll
            for (int j = 0; j < 4; ++j) { v[j] = xr[64 * j]; s += (v[j].x * v[j].x + v[j].y * v[j].y) + (v[j].z * v[j].z + v[j].w * v[j].w); }
            s = wave_sum(s);
            if (lane == 0) rstd1[m] = __builtin_amdgcn_rsqf(s * (1.0f / D_) + 1e-6f);
            GAS unsigned long long* o8 = (GAS unsigned long long*)(XB + (size_t)m * D_) + lane;
#pragma unroll
            for (int j = 0; j < 4; ++j) o8[64 * j] = (unsigned long long)pk2(v[j].x, v[j].y) | ((unsigned long long)pk2(v[j].z, v[j].w) << 32);
        }
    }
#endif
    if (IN(0)) {
        LAS float* scr = (LAS float*)(lds + wave * 16384);
        const int gw = blk * 8 + wave, NGW = G * 8;
        constexpr int I_IN = (D_ / 64) * (NIN / 32), I_O = (D_ / 64) * (D_ / 32), I_UP = (D_ / 64) * (FF_ / 32), I_DN = (FF_ / 64) * (D_ / 32);
        for (int it = gw; it < I_IN + I_O + I_UP + I_DN; it += NGW) {
            int r = it;
            if (r < I_IN) { p0_transpose_item(w_in, norm1_g, D_, NIN, WinT, scr, r, lane); continue; } r -= I_IN;
            if (r < I_O) { p0_transpose_item(w_out, nullptr, D_, D_, WoutT, scr, r, lane); continue; } r -= I_O;
            if (r < I_UP) { p0_transpose_item(w_up, norm2_g, D_, FF_, WupT, scr, r, lane); continue; } r -= I_UP;
            p0_transpose_item(w_down, nullptr, FF_, D_, WdnT, scr, r, lane);
        }
        for (int m = gw; m < M_; m += NGW) {
            const GAS f32x4* xr = (const GAS f32x4*)(x + (size_t)m * D_) + lane;
            f32x4 v[4]; float s = 0.f;
#pragma unroll
            for (int j = 0; j < 4; ++j) { v[j] = xr[64 * j]; s += (v[j].x * v[j].x + v[j].y * v[j].y) + (v[j].z * v[j].z + v[j].w * v[j].w); }
            s = wave_sum(s);
            if (lane == 0) rstd1[m] = __builtin_amdgcn_rsqf(s * (1.0f / D_) + 1e-6f);
            GAS unsigned long long* o8 = (GAS unsigned long long*)(XB + (size_t)m * D_) + lane;
#pragma unroll
            for (int j = 0; j < 4; ++j) o8[64 * j] = (unsigned long long)pk2(v[j].x, v[j].y) | ((unsigned long long)pk2(v[j].z, v[j].w) << 32);
        }
    }
    SEAM(0);
#if PROBE_PH == 1
    if (IN(1)) {
        pg8::Gemm g{XB, WinT, M_, NIN, D_}; pg8::StaticOrder S; S.init(M_, NIN, G, blk);
        pg8::EpiProj E{PROJ, NIN, rstd1};
        pg8::gemm_phase<pg8::EpiProj, pg8::StaticOrder, true, true>(lds, g, S, E);
    }
#endif
    if (IN(1)) {
        pg8::Gemm g{XB, WinT, M_, NIN, D_}; pg8::StaticOrder S; S.init(M_, NIN, G, blk);
        pg8::EpiProj E{PROJ, NIN, rstd1};
        pg8::gemm_phase<pg8::EpiProj, pg8::StaticOrder, true, true>(lds, g, S, E);
    }
    SEAM(1);
    if (IN(2)) {
        float d1 = lq1[lane] * lk1[lane], d2 = lq2[lane] * lk2[lane];
        d1 = wave_sum(d1); d2 = wave_sum(d2);
        const float lam = expf(d1) - expf(d2) + 0.2f;
        LAS unsigned* flags = (LAS unsigned*)(lds + FLAGS_OFF);
#ifndef PROBE_REP_DIFF
#define PROBE_REP_DIFF 1
#endif
#ifndef PROBE_REP_SB
#define PROBE_REP_SB 1
#endif
        for (int n = blk; n < 1024; n += G) {
            int idx = n; if ((n >> 8) & 1) idx = (n & ~255) + 255 - (n & 255);
            const int v = idx & 511, qb = 15 - (v >> 5), rem = v & 31, b = rem >> 2, hh = rem & 3;
            if (idx < 512) { for (int rep = 0; rep < PROBE_REP_DIFF; ++rep) att::diff_unit(b, hh, qb, PROJ, MIX, lds, lam, subln_g); }
            else { for (int rep = 0; rep < PROBE_REP_SB; ++rep) att::sb_unit(b, hh, qb, PROJ, MIX, lds, sb_g, flags); }
        }
    }
    SEAM(2);
#if PROBE_PH == 3
    if (IN(3)) {
        pg8::Gemm g{MIX, WoutT, M_, D_, D_}; pg8::StaticOrder S; S.init(M_, D_, G, blk);
        pg8::EpiRes E{x, out, XB, ssq2};
        pg8::gemm_phase<pg8::EpiRes, pg8::StaticOrder, true, true>(lds, g, S, E);
    }
#endif
    if (IN(3)) {
        pg8::Gemm g{MIX, WoutT, M_, D_, D_}; pg8::StaticOrder S; S.init(M_, D_, G, blk);
        pg8::EpiRes E{x, out, XB, ssq2};
        pg8::gemm_phase<pg8::EpiRes, pg8::StaticOrder, true, true>(lds, g, S, E);
    }
    SEAM(3);
#if PROBE_PH == 4
    if (IN(4)) {
        pg8::Gemm g{XB, WupT, M_, FF_, D_}; pg8::StaticOrder S; S.init(M_, FF_, G, blk);
        pg8::EpiUp E{UB, FF_, ssq2};
        pg8::gemm_phase<pg8::EpiUp, pg8::StaticOrder, true, true>(lds, g, S, E);
    }
#endif
    if (IN(4)) {
        pg8::Gemm g{XB, WupT, M_, FF_, D_}; pg8::StaticOrder S; S.init(M_, FF_, G, blk);
        pg8::EpiUp E{UB, FF_, ssq2};
        pg8::gemm_phase<pg8::EpiUp, pg8::StaticOrder, true, true>(lds, g, S, E);
    }
    SEAM(4);
#if PROBE_P5
    if (IN(5)) {
        pg8::Gemm g{UB, WdnT, M_, D_, FF_}; pg8::StaticOrder S; S.init(M_, D_, G, blk);
        pg8::EpiRes E{out, (float*)(ws + 192 * MiB), nullptr, (float*)(ws + 29 * MiB)};
        pg8::gemm_phase<pg8::EpiRes, pg8::StaticOrder, true, true>(lds, g, S, E);
    }
#endif
    if (IN(5)) {
        pg8::Gemm g{UB, WdnT, M_, D_, FF_}; pg8::StaticOrder S; S.init(M_, D_, G, blk);
        pg8::EpiRes E{out, out, nullptr, ssq3};
        pg8::gemm_phase<pg8::EpiRes, pg8::StaticOrder, true, true>(lds, g, S, E);
    }
    SEAM(5);
    if (IN(6)) {
        const int gw = blk * 8 + wave, NGW = G * 8;
        f32x4 gf[4];
#pragma unroll
        for (int j = 0; j < 4; ++j) gf[j] = ((const f32x4*)fin_g)[lane + 64 * j];
        for (int m = gw; m < M_; m += NGW) {
            float s = (lane < 16) ? ssq3[(size_t)m * 16 + lane] : 0.f;
            s = wave_sum(s);
            const float rs = __builtin_amdgcn_rsqf(s * (1.0f / D_) + 1e-6f);
            GAS f32x4* orow = (GAS f32x4*)(out + (size_t)m * D_) + lane;
#pragma unroll
            for (int j = 0; j < 4; ++j) { const f32x4 v = orow[64 * j]; orow[64 * j] = v * rs * gf[j]; }
        }
    }
#undef IN
#undef SEAM
}

extern "C" void kernel_launch(void* const* d_in, const int* in_sizes, int n_in, void* d_out, int out_size, void* d_ws, size_t ws_size, hipStream_t stream) {
    static int grid = 0;
    if (grid == 0) {
        if (n_in != 14 || in_sizes[0] != M_ * D_ || out_size != M_ * D_ || ws_size < WS_END) { fprintf(stderr, "kernel_launch: unexpected shapes (n_in %d, in0 %d, out %d, ws %zu)\n", n_in, n_in > 0 ? in_sizes[0] : -1, out_size, ws_size); grid = -1; return; }
        int dev = 0, cus = 0, per_cu = 0;
        if (hipGetDevice(&dev) != hipSuccess || hipDeviceGetAttribute(&cus, hipDeviceAttributeMultiprocessorCount, dev) != hipSuccess) { grid = -1; return; }
        if (hipFuncSetAttribute((const void*)fwd_kernel, hipFuncAttributeMaxDynamicSharedMemorySize, LDS_BYTES) != hipSuccess) { fprintf(stderr, "kernel_launch: hipFuncSetAttribute failed\n"); grid = -1; return; }
        if (hipOccupancyMaxActiveBlocksPerMultiprocessor(&per_cu, (const void*)fwd_kernel, 512, LDS_BYTES) != hipSuccess || per_cu < 1) per_cu = 1;
        (void)hipGetLastError();
        grid = cus * per_cu;
    }
    if (grid < 0) return;
    Args a{};
    for (int i = 0; i < 14; ++i) a.in[i] = (const float*)d_in[i];
    a.out = (float*)d_out; a.ws = (unsigned char*)d_ws; a.use_cg = 0; a.pad = 0;
    if (hipMemsetAsync(d_ws, 0, CTL_ZERO_BYTES, stream) != hipSuccess) { fprintf(stderr, "kernel_launch: hipMemsetAsync failed\n"); return; }
#if MK_N_LAUNCHES == 1
    a.ph_lo = 0; a.ph_hi = N_PHASES;
    void* kargs[] = {&a};
    hipError_t e = hipLaunchCooperativeKernel((const void*)fwd_kernel, dim3(grid), dim3(512), kargs, LDS_BYTES, stream);
    if (e != hipSuccess) fprintf(stderr, "kernel_launch: cooperative launch failed: %s (grid %d)\n", hipGetErrorString(e), grid);
#else
    for (int p = 0; p < N_PHASES; ++p) { a.ph_lo = p; a.ph_hi = p + 1; hipLaunchKernelGGL(fwd_kernel, dim3(grid), dim3(512), LDS_BYTES, stream, a); }
#endif
}
```
